# Optimizing an MI355X kernel written in HIP

```python
import math
import jax, jax.numpy as jnp
from jax import lax
import numpy as np


D_MODEL = 4096
BATCH = 2
SEQ = 4096
DEPTH = 2

N_MIXERS = 4
GROUP_WIDTH = D_MODEL // N_MIXERS
RMS_EPS = 1e-6

LRU_WIDTH = GROUP_WIDTH
LRU_BLOCKS = 8
LRU_BLOCK = LRU_WIDTH // LRU_BLOCKS
LRU_CONV = 4
LRU_C = 8.0

GLA_HEADS = 4
GLA_DV = GROUP_WIDTH // GLA_HEADS
GLA_DK = GLA_DV // 2
GLA_GATE_RANK = 16
GLA_TAU = 16.0
GLA_CHUNK = 64

S5_WIDTH = GROUP_WIDTH
S5_GROUP = 16
S5_GROUPS = S5_WIDTH // S5_GROUP
S5_STATE = 64
S5_DT_MIN = 0.001
S5_DT_MAX = 0.1

MOBA_HEADS = 8
MOBA_HD = GROUP_WIDTH // MOBA_HEADS
MOBA_WIDTH = MOBA_HEADS * MOBA_HD
MOBA_BLOCK = 256
MOBA_TOPK = 3
MOBA_Q_CHUNK = 32
ROPE_DIMS = MOBA_HD // 4
ROPE_THETA = 500000.0

PEER_HEADS = 8
PEER_NKEYS = 128
PEER_EXPERTS = PEER_NKEYS * PEER_NKEYS
PEER_DKEY = 256
PEER_TOPK = 16
PEER_TOKEN_CHUNK = 128

IN_SPLITS = (LRU_WIDTH, LRU_WIDTH,
             GLA_HEADS * GLA_DK, GLA_HEADS * GLA_DK, GLA_HEADS * GLA_DV, GLA_GATE_RANK, GLA_HEADS * GLA_DV,
             S5_WIDTH,
             MOBA_WIDTH, MOBA_WIDTH, MOBA_WIDTH)
IN_WIDTH = sum(IN_SPLITS)

kernel_name = 'hybrid_parallel_heads_peer'


def rms_norm(x, g):
    xf = x.astype(jnp.float32)
    xf = xf * lax.rsqrt(jnp.mean(xf * xf, axis=-1, keepdims=True) + RMS_EPS)
    return xf.astype(x.dtype) * g


def linear_scan(a, b):
    def comb(l, r):
        al, bl = l
        ar, br = r
        return al * ar, ar * bl + br
    return lax.associative_scan(comb, (a, b), axis=1)[1]


def complex_linear_scan(a_re, a_im, b_re, b_im):
    def comb(l, r):
        alr, ali, blr, bli = l
        arr, ari, brr, bri = r
        return (arr * alr - ari * ali, arr * ali + ari * alr,
                arr * blr - ari * bli + brr, arr * bli + ari * blr + bri)
    _, _, xr, xi = lax.associative_scan(comb, (a_re, a_im, b_re, b_im), axis=1)
    return xr, xi


def partial_rope(t, pos):
    half = ROPE_DIMS // 2
    inv = jnp.power(ROPE_THETA, -jnp.arange(half, dtype=jnp.float32) / half)
    ang = pos.astype(jnp.float32)[:, None] * inv[None, :]
    cos, sin = jnp.cos(ang), jnp.sin(ang)
    tf = t[..., :ROPE_DIMS].astype(jnp.float32)
    t1, t2 = tf[..., :half], tf[..., half:]
    rot = jnp.concatenate([t1 * cos - t2 * sin, t2 * cos + t1 * sin], axis=-1).astype(t.dtype)
    return jnp.concatenate([rot, t[..., ROPE_DIMS:]], axis=-1)


def rglru_mixer(xb, gb, conv_w, conv_b, wa, ba, wx, bx, lam):
    B, S, _ = xb.shape
    xc = lax.conv_general_dilated(xb, conv_w[:, None, :], window_strides=(1,),
                                  padding=[(LRU_CONV - 1, 0)],
                                  dimension_numbers=('NWC', 'WIO', 'NWC'),
                                  feature_group_count=LRU_WIDTH) + conv_b
    xblk = xc.reshape(B, S, LRU_BLOCKS, LRU_BLOCK)
    r = jax.nn.sigmoid(jnp.einsum('bsni,nij->bsnj', xblk, wa).reshape(B, S, LRU_WIDTH) + ba)
    i = jax.nn.sigmoid(jnp.einsum('bsni,nij->bsnj', xblk, wx).reshape(B, S, LRU_WIDTH) + bx)
    log_a = -LRU_C * r.astype(jnp.float32) * jax.nn.softplus(-lam.astype(jnp.float32))
    a = jnp.exp(log_a)
    mult = jnp.sqrt(-jnp.expm1(2.0 * log_a))
    h = linear_scan(a, mult * (i * xc).astype(jnp.float32))
    return h.astype(xb.dtype) * jax.nn.gelu(gb)


def gla_mixer(q, k, v, glr, og, wg2, bg, norm_g):
    B, S, _ = q.shape
    N, C = S // GLA_CHUNK, GLA_CHUNK
    f32 = jnp.float32

    def heads(t, d):
        return t.reshape(B, N, C, GLA_HEADS, d).transpose(0, 3, 1, 2, 4).astype(f32)

    g = jax.nn.log_sigmoid((glr @ wg2 + bg).astype(f32)) / GLA_TAU
    qh = heads(q, GLA_DK) * (GLA_DK ** -0.5)
    kh = heads(k, GLA_DK)
    vh = heads(v, GLA_DV)
    bc = jnp.cumsum(heads(g, GLA_DK), axis=3)
    qe = qh * jnp.exp(bc)
    ke = kh * jnp.exp(-bc)
    causal = jnp.tril(jnp.ones((C, C), dtype=bool))
    att = jnp.where(causal, jnp.einsum('bhncd,bhnjd->bhncj', qe, ke), 0.0)
    o = jnp.einsum('bhncj,bhnje->bhnce', att, vh)
    b_last = bc[:, :, :, -1:, :]
    kd = kh * jnp.exp(b_last - bc)
    U = jnp.einsum('bhncd,bhnce->nbhde', kd, vh)
    decay = jnp.exp(b_last[:, :, :, 0]).transpose(2, 0, 1, 3)

    def step(state, inp):
        dec, u = inp
        return dec[..., None] * state + u, state

    _, s_prev = lax.scan(step, jnp.zeros((B, GLA_HEADS, GLA_DK, GLA_DV), f32), (decay, U))
    o = o + jnp.einsum('bhncd,nbhde->bhnce', qe, s_prev)
    o = o.transpose(0, 2, 3, 1, 4).reshape(B, S, GLA_HEADS, GLA_DV)
    o = o * lax.rsqrt(jnp.mean(o * o, axis=-1, keepdims=True) + RMS_EPS)
    o = o.reshape(B, S, GLA_HEADS * GLA_DV).astype(q.dtype) * norm_g
    return o * jax.nn.silu(og)


def s5_mixer(u, a_re, a_im, log_step, b_re, b_im, c_re, c_im, d, w_glu, b_glu):
    B, S, _ = u.shape
    f32 = jnp.float32
    uf = u.reshape(B, S, S5_GROUPS, S5_GROUP).astype(f32)
    step = jnp.exp(log_step.astype(f32))[:, None]
    lr, li = a_re.astype(f32), a_im.astype(f32)
    mag = jnp.exp(lr * step)
    ang = li * step
    abar_re, abar_im = mag * jnp.cos(ang), mag * jnp.sin(ang)
    den = lr * lr + li * li
    f_re = ((abar_re - 1.0) * lr + abar_im * li) / den
    f_im = (abar_im * lr - (abar_re - 1.0) * li) / den
    br, bi = b_re.astype(f32), b_im.astype(f32)
    bb_re = f_re[..., None] * br - f_im[..., None] * bi
    bb_im = f_re[..., None] * bi + f_im[..., None] * br
    bu_re = jnp.einsum('bsgh,gph->bsgp', uf, bb_re)
    bu_im = jnp.einsum('bsgh,gph->bsgp', uf, bb_im)
    shape = bu_re.shape
    xr, xi = complex_linear_scan(jnp.broadcast_to(abar_re, shape), jnp.broadcast_to(abar_im, shape), bu_re, bu_im)
    y = jnp.einsum('bsgp,ghp->bsgh', xr, c_re.astype(f32)) - jnp.einsum('bsgp,ghp->bsgh', xi, c_im.astype(f32))
    y = y.reshape(B, S, S5_WIDTH) + d.astype(f32) * u.astype(f32)
    z = jax.nn.gelu(y).astype(u.dtype)
    return z * jax.nn.sigmoid(z @ w_glu + b_glu)


def moba_mixer(q, k, v):
    B, S, _ = q.shape
    f32 = jnp.float32

    def heads(t):
        return t.reshape(B, S, MOBA_HEADS, MOBA_HD).transpose(0, 2, 1, 3)

    pos = jnp.arange(S)
    qh = partial_rope(heads(q), pos)
    kh = partial_rope(heads(k), pos)
    vh = heads(v)
    nb = -(-S // MOBA_BLOCK)
    pad = nb * MOBA_BLOCK - S
    kb = jnp.pad(kh, ((0, 0), (0, 0), (0, pad), (0, 0))).reshape(B, MOBA_HEADS, nb, MOBA_BLOCK, MOBA_HD)
    vb = jnp.pad(vh, ((0, 0), (0, 0), (0, pad), (0, 0))).reshape(B, MOBA_HEADS, nb, MOBA_BLOCK, MOBA_HD)
    kmean = jnp.mean(kb.astype(f32), axis=3)
    n_sel = min(MOBA_TOPK, nb)
    nqc = S // MOBA_Q_CHUNK
    qc = qh.reshape(B, MOBA_HEADS, nqc, MOBA_Q_CHUNK, MOBA_HD).transpose(2, 0, 1, 3, 4)
    scale = MOBA_HD ** -0.5
    gather = jax.vmap(jax.vmap(lambda blocks, ix: blocks[ix]))

    def chunk(args):
        qi, ci = args
        q_pos = ci * MOBA_Q_CHUNK + jnp.arange(MOBA_Q_CHUNK)
        own = (ci * MOBA_Q_CHUNK) // MOBA_BLOCK
        qf = qi.astype(f32)
        gate = jnp.einsum('bhqd,bhnd->bhqn', qf, kmean)
        gate = jnp.where(jnp.arange(nb) < own, gate, -jnp.inf)
        _, idx = lax.top_k(gate, n_sel)
        valid = jnp.arange(n_sel) < own
        kg = gather(kb, idx).astype(f32)
        vg = gather(vb, idx).astype(f32)
        s_sel = jnp.einsum('bhqd,bhqmkd->bhqmk', qf, kg) * scale
        s_sel = jnp.where(valid[:, None], s_sel, -jnp.inf).reshape(B, MOBA_HEADS, MOBA_Q_CHUNK, n_sel * MOBA_BLOCK)
        k_own = lax.dynamic_index_in_dim(kb, own, axis=2, keepdims=False).astype(f32)
        v_own = lax.dynamic_index_in_dim(vb, own, axis=2, keepdims=False).astype(f32)
        s_own = jnp.einsum('bhqd,bhkd->bhqk', qf, k_own) * scale
        k_pos = own * MOBA_BLOCK + jnp.arange(MOBA_BLOCK)
        s_own = jnp.where(k_pos[None, :] <= q_pos[:, None], s_own, -jnp.inf)
        p = jax.nn.softmax(jnp.concatenate([s_sel, s_own], axis=-1), axis=-1)
        p_sel = p[..., :n_sel * MOBA_BLOCK].reshape(B, MOBA_HEADS, MOBA_Q_CHUNK, n_sel, MOBA_BLOCK)
        p_own = p[..., n_sel * MOBA_BLOCK:]
        o = jnp.einsum('bhqmk,bhqmkd->bhqd', p_sel, vg) + jnp.einsum('bhqk,bhkd->bhqd', p_own, v_own)
        return o.astype(q.dtype)

    out = lax.map(chunk, (qc, jnp.arange(nqc)))
    return out.transpose(1, 0, 3, 2, 4).reshape(B, S, MOBA_WIDTH)


def peer_ffn(h, wq, subkeys, u_tab, v_tab):
    B, S, D = h.shape
    T = B * S
    ht = h.reshape(T, D)
    q = (ht @ wq).reshape(T, PEER_HEADS, 2, PEER_DKEY // 2).astype(jnp.float32)
    s = jnp.einsum('thcd,hckd->thck', q, subkeys.astype(jnp.float32))
    v1, i1 = lax.top_k(s[:, :, 0], PEER_TOPK)
    v2, i2 = lax.top_k(s[:, :, 1], PEER_TOPK)
    cand = (v1[..., :, None] + v2[..., None, :]).reshape(T, PEER_HEADS, PEER_TOPK * PEER_TOPK)
    sc, ci = lax.top_k(cand, PEER_TOPK)
    e1 = jnp.take_along_axis(i1, ci // PEER_TOPK, axis=-1)
    e2 = jnp.take_along_axis(i2, ci % PEER_TOPK, axis=-1)
    experts = (e1 * PEER_NKEYS + e2).reshape(T, PEER_HEADS * PEER_TOPK)
    gates = jax.nn.softmax(sc, axis=-1).reshape(T, PEER_HEADS * PEER_TOPK)
    nc = T // PEER_TOKEN_CHUNK

    def chunk(args):
        xc, ec, gc = args
        act = jax.nn.gelu(jnp.einsum('td,tkd->tk', xc, u_tab[ec]).astype(jnp.float32), approximate=False)
        w = (gc * act).astype(xc.dtype)
        return jnp.einsum('tk,tkd->td', w, v_tab[ec])

    out = lax.map(chunk, (ht.reshape(nc, PEER_TOKEN_CHUNK, D),
                          experts.reshape(nc, PEER_TOKEN_CHUNK, -1),
                          gates.reshape(nc, PEER_TOKEN_CHUNK, -1)))
    return out.reshape(B, S, D)


def setup_inputs(seed: int = 0) -> dict:
    key = jax.random.key(seed)
    ks = jax.random.split(key, 32)
    f32 = jnp.float32
    L = DEPTH

    def nrm(k, shape, scale):
        return jax.random.normal(k, shape, f32) * scale

    a0 = jax.random.uniform(ks[9], (L, LRU_WIDTH), f32, 0.9, 0.999)
    s0 = a0 ** (1.0 / LRU_C)
    return {
        'x': nrm(ks[0], (BATCH, SEQ, D_MODEL), 1.0),
        'norm1_g': 1.0 + nrm(ks[1], (L, D_MODEL), 0.02),
        'w_in': nrm(ks[2], (L, D_MODEL, IN_WIDTH), D_MODEL ** -0.5),
        'lru_conv_w': nrm(ks[3], (L, LRU_CONV, LRU_WIDTH), LRU_CONV ** -0.5),
        'lru_conv_b': nrm(ks[4], (L, LRU_WIDTH), 0.01),
        'lru_wa': nrm(ks[5], (L, LRU_BLOCKS, LRU_BLOCK, LRU_BLOCK), LRU_BLOCK ** -0.5),
        'lru_ba': nrm(ks[6], (L, LRU_WIDTH), 0.01),
        'lru_wx': nrm(ks[7], (L, LRU_BLOCKS, LRU_BLOCK, LRU_BLOCK), LRU_BLOCK ** -0.5),
        'lru_bx': nrm(ks[8], (L, LRU_WIDTH), 0.01),
        'lru_lambda': jnp.log(s0) - jnp.log1p(-s0),
        'gla_wg2': nrm(ks[10], (L, GLA_GATE_RANK, GLA_HEADS * GLA_DK), GLA_GATE_RANK ** -0.5),
        'gla_bg': nrm(ks[11], (L, GLA_HEADS * GLA_DK), 0.01),
        'gla_norm_g': 1.0 + nrm(ks[12], (L, GLA_HEADS * GLA_DV), 0.02),
        's5_a_re': -0.5 + nrm(ks[13], (L, S5_GROUPS, S5_STATE), 0.01),
        's5_a_im': math.pi * jnp.arange(S5_STATE, dtype=f32) + nrm(ks[14], (L, S5_GROUPS, S5_STATE), 0.01),
        's5_log_step': jax.random.uniform(ks[15], (L, S5_GROUPS), f32, math.log(S5_DT_MIN), math.log(S5_DT_MAX)),
        's5_b_re': nrm(ks[16], (L, S5_GROUPS, S5_STATE, S5_GROUP), (2 * S5_GROUP) ** -0.5),
        's5_b_im': nrm(ks[17], (L, S5_GROUPS, S5_STATE, S5_GROUP), (2 * S5_GROUP) ** -0.5),
        's5_c_re': nrm(ks[18], (L, S5_GROUPS, S5_GROUP, S5_STATE), 1.0),
        's5_c_im': nrm(ks[19], (L, S5_GROUPS, S5_GROUP, S5_STATE), 1.0),
        's5_d': nrm(ks[20], (L, S5_WIDTH), 0.5),
        's5_w_glu': nrm(ks[21], (L, S5_WIDTH, S5_WIDTH), S5_WIDTH ** -0.5),
        's5_b_glu': nrm(ks[22], (L, S5_WIDTH), 0.01),
        'w_out': nrm(ks[23], (L, N_MIXERS * GROUP_WIDTH, D_MODEL), (N_MIXERS * GROUP_WIDTH) ** -0.5),
        'norm2_g': 1.0 + nrm(ks[24], (L, D_MODEL), 0.02),
        'peer_wq': nrm(ks[25], (L, D_MODEL, PEER_HEADS * PEER_DKEY), D_MODEL ** -0.5),
        'peer_subkeys': nrm(ks[26], (L, PEER_HEADS, 2, PEER_NKEYS, PEER_DKEY // 2), (PEER_DKEY // 2) ** -0.5),
        'peer_u': nrm(ks[27], (L, PEER_EXPERTS, D_MODEL), D_MODEL ** -0.5),
        'peer_v': nrm(ks[28], (L, PEER_EXPERTS, D_MODEL), PEER_HEADS ** -0.5),
        'final_norm_g': 1.0 + nrm(ks[29], (D_MODEL,), 0.02),
    }


def reference(x, norm1_g, w_in, lru_conv_w, lru_conv_b, lru_wa, lru_ba, lru_wx, lru_bx, lru_lambda,
              gla_wg2, gla_bg, gla_norm_g, s5_a_re, s5_a_im, s5_log_step, s5_b_re, s5_b_im, s5_c_re, s5_c_im,
              s5_d, s5_w_glu, s5_b_glu, w_out, norm2_g, peer_wq, peer_subkeys, peer_u, peer_v, final_norm_g):
    split_points = [int(p) for p in np.cumsum(IN_SPLITS)[:-1]]
    for l in range(DEPTH):
        h = rms_norm(x, norm1_g[l])
        proj = h @ w_in[l]
        (lru_x, lru_gate, gla_q, gla_k, gla_v, gla_lr, gla_og, s5_u,
         moba_q, moba_k, moba_v) = jnp.split(proj, split_points, axis=-1)
        y_a = rglru_mixer(lru_x, lru_gate, lru_conv_w[l], lru_conv_b[l], lru_wa[l], lru_ba[l],
                          lru_wx[l], lru_bx[l], lru_lambda[l])
        y_b = gla_mixer(gla_q, gla_k, gla_v, gla_lr, gla_og, gla_wg2[l], gla_bg[l], gla_norm_g[l])
        y_c = s5_mixer(s5_u, s5_a_re[l], s5_a_im[l], s5_log_step[l], s5_b_re[l], s5_b_im[l],
                       s5_c_re[l], s5_c_im[l], s5_d[l], s5_w_glu[l], s5_b_glu[l])
        y_d = moba_mixer(moba_q, moba_k, moba_v)
        mixed = jnp.concatenate([y_a.astype(x.dtype), y_b.astype(x.dtype),
                                 y_c.astype(x.dtype), y_d.astype(x.dtype)], axis=-1)
        x = x + mixed @ w_out[l]
        x = x + peer_ffn(rms_norm(x, norm2_g[l]), peer_wq[l], peer_subkeys[l], peer_u[l], peer_v[l])
    return rms_norm(x, final_norm_g)
```

```cpp
#include <hip/hip_runtime.h>
#define KFN __global__ __launch_bounds__(256) void
#define GID() ((long)blockIdx.x * (long)blockDim.x + (long)threadIdx.x)
#define LAUNCH(k, n, ...) hipLaunchKernelGGL(k, dim3((unsigned)((((long)(n)) + 255) / 256)), dim3(256), 0, stream, __VA_ARGS__, (long)(n))
#define DEVFN __device__ __forceinline__
#include <math.h>
namespace pg8 {
#define PG8_LAS __attribute__((address_space(3)))
typedef unsigned short bf16_t;
typedef short bf16x8 __attribute__((ext_vector_type(8)));
typedef float f32x4 __attribute__((ext_vector_type(4)));
typedef unsigned u32x4 __attribute__((ext_vector_type(4)));
constexpr int BM = 256, BK = 64, HALF = 128, HTB = HALF * BK * 2  , STAGE_BYTES = 8 * HTB, NXCD = 8, WGM = 8;

__host__ __device__ __forceinline__ int lds_byte(int r, int c) { const int st = (r >> 4) * 2 + (c >> 5), rr = r & 15, cc = c & 31, ob = rr * 64 + cc * 2; return st * 1024 + (ob ^ (((ob >> 9) & 1) << 5)); }
__host__ __device__ __forceinline__ void stage_rc(int b, int& R, int& C) { const int st = b / 1024, sb = b % 1024, swz = sb ^ (((sb >> 9) & 1) << 5); R = (st >> 1) * 16 + swz / 64; C = (st & 1) * 32 + (swz % 64) / 2; }
__host__ __device__ __forceinline__ int perm32(int rho) { const int n = rho >> 4, i = rho & 15; return 8 * (i >> 2) + 4 * n + (i & 3); }

struct Unit { int pm, pn; };
struct Gemm { const bf16_t* A; const bf16_t* Bt; int M, N, K; };

struct StaticOrder {
    int nM, nN, nwg, G, c;
    __host__ __device__ void init(int M, int N, int G_, int c_) { nM = M / BM; nN = N / BM; nwg = nM * nN; G = G_; c = c_; }
    __host__ __device__ bool next(int i, Unit& u) const {
        const long L = (long)i * G + c; if (L >= nwg) return false;
        int wgid = (int)L; { const int q = nwg / NXCD, r = nwg % NXCD, xcd = wgid % NXCD, off = wgid / NXCD; wgid = (xcd < r ? xcd * (q + 1) : r * (q + 1) + (xcd - r) * q) + off; }
        const int nig = WGM * nN, gid = wgid / nig, fm = gid * WGM, gsz = (nM - fm) < WGM ? (nM - fm) : WGM;
        u.pm = fm + ((wgid % nig) % gsz); u.pn = (wgid % nig) / gsz; return true;
    }
    __device__ __forceinline__ void a_ready(const Unit&) const {}
    __device__ __forceinline__ void done(const Unit&) const {}
};
struct CountedOrder : StaticOrder {
    const unsigned* ready; unsigned need; unsigned* tmo;
    __device__ __forceinline__ void a_ready(const Unit& u) const {
        if (threadIdx.x < 64) {
            const unsigned long long t0 = __builtin_amdgcn_s_memrealtime(); unsigned polls = 0;
            while ((unsigned)__builtin_amdgcn_readfirstlane(__hip_atomic_load(ready + 64 * u.pm, __ATOMIC_RELAXED, __HIP_MEMORY_SCOPE_AGENT)) < need) {
                if ((++polls & 255u) == 0u && __builtin_amdgcn_readfirstlane(__hip_atomic_load(tmo, __ATOMIC_RELAXED, __HIP_MEMORY_SCOPE_AGENT)) != 0u) break;
                if (__builtin_amdgcn_s_memrealtime() - t0 > 2000000ull) {
                    if (threadIdx.x == 0) { unsigned expect = 0u; __hip_atomic_compare_exchange_strong(tmo + 1, &expect, 0x600u | (unsigned)(u.pm & 0xff), __ATOMIC_RELAXED, __ATOMIC_RELAXED, __HIP_MEMORY_SCOPE_AGENT); __hip_atomic_store(tmo, 1u, __ATOMIC_RELAXED, __HIP_MEMORY_SCOPE_AGENT); }
                    break; }
                __builtin_amdgcn_s_sleep(2); }
            __builtin_amdgcn_fence(__ATOMIC_ACQUIRE, "agent");
            asm volatile("s_waitcnt vmcnt(0)" ::: "memory");
        }
#if !defined(BROKEN_HOOK_NO_BARRIER)
        asm volatile("" ::: "memory"); __builtin_amdgcn_s_barrier(); asm volatile("" ::: "memory");
#endif
    }
};

__device__ __forceinline__ unsigned cvt_pk_bf16(float lo, float hi) { unsigned r; asm volatile("v_cvt_pk_bf16_f32 %0, %1, %2" : "=v"(r) : "v"(lo), "v"(hi)); return r; }
typedef float f32x2 __attribute__((ext_vector_type(2)));
__device__ __forceinline__ f32x2 gelu_pk(f32x2 v) {
    const f32x2 av = __builtin_elementwise_abs(v), d = av * 0.2316418882f + 1.0f;
    f32x2 t; t.x = __builtin_amdgcn_rcpf(d.x); t.y = __builtin_amdgcn_rcpf(d.y);
    f32x2 q = t * 0.5307027145f + (-0.7265760135f); q = q * t + 0.7107068705f; q = q * t + (-0.142248368f); q = q * t + 0.127414796f; q = q * t;
    const f32x2 s = (v * v) * (-0.72134752044f);
    f32x2 e; e.x = __builtin_amdgcn_exp2f(s.x); e.y = __builtin_amdgcn_exp2f(s.y);
    const f32x2 m = v * (q * e), r = v - m;
    f32x2 o; o.x = v.x < 0.f ? m.x : r.x; o.y = v.y < 0.f ? m.y : r.y; return o;
}

struct EpiF32 {
    static constexpr bool PERM = false, AFTER_DRAIN = false;
    float* C; int ldc; const float* bias;
    __device__ __forceinline__ void operator()(const f32x4 (&acc)[2][2][4][2], const Unit& u, int wr, int wc, int fr, int fq) const {
        const int row0 = u.pm * BM + wr * 64 + fr, col0 = u.pn * BM + wc * 32 + 4 * fq;
        f32x4 bv[2][2];
#pragma unroll
        for (int bj = 0; bj < 2; ++bj)
#pragma unroll
            for (int n = 0; n < 2; ++n) bv[bj][n] = bias ? *(const f32x4*)(bias + col0 + bj * HALF + n * 16) : (f32x4){0.f, 0.f, 0.f, 0.f};
#pragma unroll
        for (int ai = 0; ai < 2; ++ai)
#pragma unroll
            for (int m = 0; m < 4; ++m) { float* rowp = C + (size_t)(row0 + ai * HALF + m * 16) * ldc + col0;
#pragma unroll
                for (int bj = 0; bj < 2; ++bj)
#pragma unroll
                    for (int n = 0; n < 2; ++n) *(f32x4*)(rowp + bj * HALF + n * 16) = acc[ai][bj][m][n] + bv[bj][n]; }
    }
};
template <int ACT  > struct EpiBf16 {
    static constexpr bool PERM = true, AFTER_DRAIN = false;
    bf16_t* O; int ldc; const float* bias; int split_cols; size_t split_stride;
    __device__ __forceinline__ void operator()(const f32x4 (&acc)[2][2][4][2], const Unit& u, int wr, int wc, int fr, int fq) const {
        const int row0 = u.pm * BM + wr * 64 + fr; int colt = u.pn * BM; bf16_t* base = O;
        if (split_cols) { const int t = colt / split_cols; base += (size_t)t * split_stride; colt -= t * split_cols; }
        const int col0 = colt + wc * 32 + 8 * fq, bcol0 = u.pn * BM + wc * 32 + 8 * fq;
        f32x4 bv[2][2];
#pragma unroll
        for (int bj = 0; bj < 2; ++bj)
#pragma unroll
            for (int n = 0; n < 2; ++n) bv[bj][n] = bias ? *(const f32x4*)(bias + bcol0 + bj * HALF + 4 * n) : (f32x4){0.f, 0.f, 0.f, 0.f};
#pragma unroll
        for (int ai = 0; ai < 2; ++ai)
#pragma unroll
            for (int m = 0; m < 4; ++m) { bf16_t* rowp = base + (size_t)(row0 + ai * HALF + m * 16) * ldc + col0;
#pragma unroll
                for (int bj = 0; bj < 2; ++bj) { f32x4 v0 = acc[ai][bj][m][0] + bv[bj][0], v1 = acc[ai][bj][m][1] + bv[bj][1];
                    if (ACT == 1) { f32x2 a = gelu_pk((f32x2){v0[0], v0[1]}), b = gelu_pk((f32x2){v0[2], v0[3]}), c = gelu_pk((f32x2){v1[0], v1[1]}), d = gelu_pk((f32x2){v1[2], v1[3]});
                        v0 = (f32x4){a.x, a.y, b.x, b.y}; v1 = (f32x4){c.x, c.y, d.x, d.y}; }
                    if (ACT == 2) {
#pragma unroll
                        for (int j = 0; j < 4; ++j) { v0[j] = 0.5f * v0[j] * (1.0f + erff(v0[j] * 0.70710678f)); v1[j] = 0.5f * v1[j] * (1.0f + erff(v1[j] * 0.70710678f)); } }
                    u32x4 w; w.x = cvt_pk_bf16(v0[0], v0[1]); w.y = cvt_pk_bf16(v0[2], v0[3]); w.z = cvt_pk_bf16(v1[0], v1[1]); w.w = cvt_pk_bf16(v1[2], v1[3]);
                    *(u32x4*)(rowp + bj * HALF) = w; } }
    }
};
template <class Epi, class Sched, bool STAMP = false>
__device__ __forceinline__ void gemm_phase(PG8_LAS unsigned char* lds, const Gemm g, const Sched& S, const Epi& E, unsigned long long* stamps) {
    int tid_ = threadIdx.x; asm volatile("" : "+v"(tid_));
    const int tid = tid_, wid = __builtin_amdgcn_readfirstlane(tid >> 6), lane = tid & 63, wr = wid >> 2, wc = wid & 3, fr = lane & 15, fq = lane >> 4;
    const int K = g.K, nt = K / BK;
    int ts_lo = 0, ts_hi = 0, nts = 0; const unsigned long long rt_entry = STAMP ? (unsigned long long)wall_clock64() : 0ull;
#define PG8_STAMP() do { if (STAMP && wid == 0 && nts < 64) { const unsigned long long _c = (unsigned long long)clock64(); \
        ts_lo = (lane == nts) ? (int)(unsigned)_c : ts_lo; ts_hi = (lane == nts) ? (int)(unsigned)(_c >> 32) : ts_hi; ++nts; } } while (0)
    PG8_STAMP();
    unsigned voffA[2], voffB[2];
#pragma unroll
    for (int i = 0; i < 2; ++i) { int R, C; stage_rc(tid * 16 + i * 8192, R, C); const int Rb = Epi::PERM ? ((R & ~31) + perm32(R & 31)) : R;
        voffA[i] = (unsigned)(R * K + C) * 2u; voffB[i] = (unsigned)(Rb * K + C) * 2u; }
    const size_t kstep = (size_t)(BK * 2);
    const size_t hstep = (size_t)HALF * K * 2;
    const size_t tstep = 2 * hstep;
    const unsigned ldsw = (unsigned)wid * 1024u;
    const int aoff = lds_byte(wr * 64 + fr, fq * 8), boff = lds_byte(wc * 32 + fr, fq * 8);
#define PG8_SA(b, h) (((b) * 2 + (h)) * HTB)
#define PG8_SB(b, h) ((4 + (b) * 2 + (h)) * HTB)
#define PG8_STAGE(bufoff, gbase, voff) do { _Pragma("unroll") for (int _i = 0; _i < 2; ++_i) \
        __builtin_amdgcn_global_load_lds((const unsigned*)((const char*)(gbase) + (voff)[_i]), (PG8_LAS unsigned*)(lds + (bufoff) + ldsw + _i * 8192), 16, 0, 0); } while (0)
#define PG8_LDA(dst, b, h) do { _Pragma("unroll") for (int m = 0; m < 4; ++m) _Pragma("unroll") for (int k = 0; k < 2; ++k) dst[m][k] = *(const PG8_LAS bf16x8*)(lds + PG8_SA(b, h) + aoff + m * 2048 + k * 1024); } while (0)
#define PG8_LDB(dst, b, h) do { _Pragma("unroll") for (int n = 0; n < 2; ++n) _Pragma("unroll") for (int k = 0; k < 2; ++k) dst[n][k] = *(const PG8_LAS bf16x8*)(lds + PG8_SB(b, h) + boff + n * 2048 + k * 1024); } while (0)
#define PG8_MMA(ai, bj, At, Bt) do { __builtin_amdgcn_s_setprio(1); _Pragma("unroll") for (int m = 0; m < 4; ++m) _Pragma("unroll") for (int n = 0; n < 2; ++n) _Pragma("unroll") for (int k = 0; k < 2; ++k) \
        acc[ai][bj][m][n] = __builtin_amdgcn_mfma_f32_16x16x32_bf16(Bt[n][k], At[m][k], acc[ai][bj][m][n], 0, 0, 0); __builtin_amdgcn_s_setprio(0); } while (0)
#define PG8_WAIT_V(n) asm volatile("s_waitcnt vmcnt(" #n ")" ::: "memory")
#define PG8_WAIT_L(n) asm volatile("s_waitcnt lgkmcnt(" #n ")" ::: "memory")
#define PG8_BAR __builtin_amdgcn_s_barrier()
#define PG8_SCHED __builtin_amdgcn_sched_barrier(0)
    Unit cur, nxt; int ui = 0;
    if (!S.next(0, cur)) return;
    f32x4 acc[2][2][4][2];
#pragma unroll
    for (int a = 0; a < 2; ++a)
#pragma unroll
        for (int b = 0; b < 2; ++b)
#pragma unroll
            for (int m = 0; m < 4; ++m)
#pragma unroll
                for (int n = 0; n < 2; ++n) acc[a][b][m][n] = (f32x4){0.f, 0.f, 0.f, 0.f};
    bf16x8 At[4][2], B0[2][2], B1[2][2];
    const char* cA = (const char*)g.A + (size_t)cur.pm * tstep; const char* cB = (const char*)g.Bt + (size_t)cur.pn * tstep;
    S.a_ready(cur);
    PG8_STAGE(PG8_SB(0, 0), cB, voffB); PG8_STAGE(PG8_SA(0, 0), cA, voffA); PG8_STAGE(PG8_SB(0, 1), cB + hstep, voffB); PG8_STAGE(PG8_SA(0, 1), cA + hstep, voffA);
    if (wr == 1) PG8_BAR;
    PG8_WAIT_V(4); PG8_BAR;
    PG8_STAGE(PG8_SB(1, 0), cB + kstep, voffB); PG8_STAGE(PG8_SA(1, 0), cA + kstep, voffA); PG8_STAGE(PG8_SB(1, 1), cB + hstep + kstep, voffB);
    PG8_WAIT_V(6); PG8_BAR;
    PG8_STAMP();
    for (;;) {
        const bool has_next = S.next(ui + 1, nxt);
        const char* nA = has_next ? (const char*)g.A + (size_t)nxt.pm * tstep : cA; const char* nB = has_next ? (const char*)g.Bt + (size_t)nxt.pn * tstep : cB;
        for (int t = 0; t < nt; t += 2) {
            const bool last = (t == nt - 2);
            const char* a1 = cA + (size_t)(t + 1) * kstep;
            const char* a2 = last ? nA : cA + (size_t)(t + 2) * kstep; const char* b2 = last ? nB : cB + (size_t)(t + 2) * kstep;
            const char* a3 = a2 + kstep; const char* b3 = b2 + kstep;
            if (last && has_next) S.a_ready(nxt);
            PG8_LDB(B0, 0, 0); PG8_SCHED; PG8_LDA(At, 0, 0); PG8_STAGE(PG8_SA(1, 1), a1 + hstep, voffA);
            PG8_WAIT_L(8); PG8_BAR; PG8_WAIT_L(0); PG8_MMA(0, 0, At, B0); PG8_BAR; PG8_SCHED;
            PG8_LDB(B1, 0, 1); PG8_STAGE(PG8_SB(0, 0), b2, voffB);
            PG8_BAR; PG8_WAIT_L(0); PG8_MMA(0, 1, At, B1); PG8_BAR;
            PG8_LDA(At, 0, 1); PG8_STAGE(PG8_SA(0, 0), a2, voffA);
            PG8_BAR; PG8_WAIT_L(0); PG8_MMA(1, 0, At, B0); PG8_BAR; PG8_SCHED;
            PG8_STAGE(PG8_SB(0, 1), b2 + hstep, voffB);
            PG8_WAIT_V(6); PG8_BAR; PG8_MMA(1, 1, At, B1); PG8_BAR;
            PG8_LDB(B0, 1, 0); PG8_SCHED; PG8_LDA(At, 1, 0); PG8_STAGE(PG8_SA(0, 1), a2 + hstep, voffA);
            PG8_WAIT_L(8); PG8_BAR; PG8_WAIT_L(0); PG8_MMA(0, 0, At, B0); PG8_BAR; PG8_SCHED;
            PG8_LDB(B1, 1, 1); PG8_STAGE(PG8_SB(1, 0), b3, voffB);
            PG8_BAR; PG8_WAIT_L(0); PG8_MMA(0, 1, At, B1); PG8_BAR;
            PG8_LDA(At, 1, 1); PG8_STAGE(PG8_SA(1, 0), a3, voffA);
            PG8_BAR; PG8_WAIT_L(0); PG8_MMA(1, 0, At, B0); PG8_BAR; PG8_SCHED;
            PG8_STAGE(PG8_SB(1, 1), b3 + hstep, voffB);
            PG8_WAIT_V(6); PG8_BAR; PG8_MMA(1, 1, At, B1); PG8_BAR;
        }
        PG8_STAMP();
        if constexpr (!Epi::AFTER_DRAIN) { E(acc, cur, wr, wc, fr, fq); S.done(cur); }
        PG8_STAMP();
        if (!has_next) break;
#pragma unroll
        for (int a = 0; a < 2; ++a)
#pragma unroll
            for (int b = 0; b < 2; ++b)
#pragma unroll
                for (int m = 0; m < 4; ++m)
#pragma unroll
                    for (int n = 0; n < 2; ++n) acc[a][b][m][n] = (f32x4){0.f, 0.f, 0.f, 0.f};
        cur = nxt; cA = nA; cB = nB; ++ui;
    }
    PG8_WAIT_V(0);
    if (wr == 0) PG8_BAR;
    PG8_BAR;
    if constexpr (Epi::AFTER_DRAIN) { E.fused(acc, cur, wr, wc, fr, fq, lds, wid, lane); S.done(cur); }
    PG8_STAMP();
    if (STAMP && wid == 0) { stamps[lane] = lane < nts ? (((unsigned long long)(unsigned)ts_hi << 32) | (unsigned)ts_lo) : 0ull;
        if (lane == 62) stamps[62] = rt_entry; if (lane == 63) stamps[63] = (unsigned long long)wall_clock64(); }
#undef PG8_STAMP
#undef PG8_SA
#undef PG8_SB
#undef PG8_STAGE
#undef PG8_LDA
#undef PG8_LDB
#undef PG8_MMA
#undef PG8_WAIT_V
#undef PG8_WAIT_L
#undef PG8_BAR
#undef PG8_SCHED
}
}


#ifndef CFG_D_MODEL
#define CFG_D_MODEL 4096
#define CFG_SEQ 4096
#define CFG_S5_STATE 64
#define CFG_MOBA_BLOCK 256
#define CFG_PEER_NKEYS 128
#define CFG_PEER_DKEY 256
#define CFG_PEER_TOPK 16
#endif
constexpr int D = CFG_D_MODEL, NB = 2, S = CFG_SEQ, T = NB * S, NL = 2;
constexpr int GW = D / 4;
constexpr int LRU_NBLK = 8, LRU_BLK = GW / LRU_NBLK;
constexpr int GLA_H = 4, GLA_DV = GW / GLA_H, GLA_DK = GLA_DV / 2, GLA_R = 16, GLA_HK = GLA_H * GLA_DK;
constexpr int S5_HG = 16, S5_G = GW / S5_HG, S5_P = CFG_S5_STATE, S5_GP = S5_G * S5_P;
constexpr int MB_H = 8, MB_HD = GW / MB_H, MB_BLK = CFG_MOBA_BLOCK, MB_NB = S / MB_BLK, MB_ROPE = MB_HD / 4, MB_SLOTS = 4 * MB_BLK;
constexpr int PE_H = 8, PE_NK = CFG_PEER_NKEYS, PE_E = PE_NK * PE_NK, PE_DK = CFG_PEER_DKEY, PE_DH = PE_DK / 2, PE_K = CFG_PEER_TOPK, PE_HK = PE_H * PE_K, PE_QW = PE_H * PE_DK;
constexpr int C_LRUX = 0, C_LRUG = GW, C_GQ = 2 * GW, C_GK = C_GQ + GLA_HK, C_GV = C_GK + GLA_HK, C_GLR = C_GV + GW, C_GOG = C_GLR + GLA_R,
              C_S5U = C_GOG + GW, C_MQ = C_S5U + GW, C_MK = C_MQ + GW, C_MV = C_MK + GW, INW = C_MV + GW, PLD = ((INW + 255) / 256) * 256;
constexpr float RMS_EPS = 1e-6f;
typedef unsigned short bf16_t;
DEVFN bf16_t f2bf(float f) { unsigned u = __float_as_uint(f); u += 0x7FFFu + ((u >> 16) & 1u); return (bf16_t)(u >> 16); }
DEVFN float bf2f(bf16_t b) { return __uint_as_float(((unsigned)b) << 16); }
DEVFN unsigned pack2bf(float lo, float hi) { return (unsigned)f2bf(lo) | ((unsigned)f2bf(hi) << 16); }

struct P {
    const float *x, *norm1_g, *w_in, *lru_conv_w, *lru_conv_b, *lru_wa, *lru_ba, *lru_wx, *lru_bx, *lru_lambda;
    const float *gla_wg2, *gla_bg, *gla_norm_g, *s5_a_re, *s5_a_im, *s5_log_step, *s5_b_re, *s5_b_im, *s5_c_re, *s5_c_im;
    const float *s5_d, *s5_w_glu, *s5_b_glu, *w_out, *norm2_g, *peer_wq, *peer_subkeys, *peer_u, *peer_v, *final_norm_g;
    float *out;
    float *xa, *xb, *proj, *rstd, *sumsq; bf16_t *xbf, *mixedb, *s5zb, *G, *Pm;
    bf16_t *WinT, *WoutT, *WqT, *GluT, *Ub, *Vt;
    float *lxc, *lA, *lB;
    float *galpha, *goraw, *gorstd;
    float *s5abar, *s5bb, *s5z, *s5lin;
    float *mqr, *mkr, *mkmean, *mstat; int *midx;
    float *big;
    float *pq, *ps, *pv, *psc, *pgate, *pw; int *pi, *pexp;
    int pad0, pad1;
};

DEVFN float sigmoidf_(float x) { return 1.0f / (1.0f + expf(-x)); }
DEVFN float softplusf_(float x) { return fmaxf(x, 0.0f) + log1pf(expf(-fabsf(x))); }
DEVFN float gelu_tanhf_(float x) { return 0.5f * x * (1.0f + tanhf(0.7978845608028654f * (x + 0.044715f * x * x * x))); }
DEVFN float gelu_erff_(float x) { return 0.5f * x * (1.0f + erff(x * 0.7071067811865476f)); }

DEVFN void b_lru_conv(const P& p, const int l, long gid) {
    long t = gid / GW; int c = (int)(gid % GW); int s = (int)(t % S);
    const float* cw = p.lru_conv_w + (size_t)l * 4 * GW;
    float acc = p.lru_conv_b[(size_t)l * GW + c];
    for (int j = 0; j < 4; ++j) { int ss = s - 3 + j; if (ss >= 0) acc += cw[j * GW + c] * p.proj[(size_t)(t - 3 + j) * PLD + C_LRUX + c]; }
    p.lxc[gid] = acc;
}
DEVFN void b_lru_gate(const P& p, const int l, long gid) {
    long t = gid / GW; int c = (int)(gid % GW); int blk = c / LRU_BLK, j = c % LRU_BLK;
    const float* wa = p.lru_wa + ((size_t)l * LRU_NBLK + blk) * LRU_BLK * LRU_BLK;
    const float* wx = p.lru_wx + ((size_t)l * LRU_NBLK + blk) * LRU_BLK * LRU_BLK;
    const float* xr = p.lxc + (size_t)t * GW + blk * LRU_BLK;
    float ra = 0.f, rx = 0.f;
    for (int i = 0; i < LRU_BLK; ++i) { float xv = xr[i]; ra += xv * wa[i * LRU_BLK + j]; rx += xv * wx[i * LRU_BLK + j]; }
    float r = sigmoidf_(ra + p.lru_ba[(size_t)l * GW + c]);
    float ig = sigmoidf_(rx + p.lru_bx[(size_t)l * GW + c]);
    float log_a = -8.0f * r * softplusf_(-p.lru_lambda[(size_t)l * GW + c]);
    float a = expf(log_a);
    float mult = sqrtf(-expm1f(2.0f * log_a));
    p.lA[gid] = a; p.lB[gid] = mult * (ig * p.lxc[gid]);
}
DEVFN void b_lru_scan(const P& p, const int l, long gid) {
    int b = (int)(gid / GW), c = (int)(gid % GW);
    float h = 0.f;
    for (int s = 0; s < S; ++s) {
        size_t t = (size_t)b * S + s;
        h = p.lA[t * GW + c] * h + p.lB[t * GW + c];
        p.mixedb[t * D + c] = f2bf(h * gelu_tanhf_(p.proj[t * PLD + C_LRUG + c]));
    }
}

DEVFN void b_gla_g(const P& p, const int l, long gid) {
    long t = gid / GLA_HK; int j = (int)(gid % GLA_HK);
    const float* w = p.gla_wg2 + (size_t)l * GLA_R * GLA_HK;
    float acc = p.gla_bg[(size_t)l * GLA_HK + j];
    for (int r = 0; r < GLA_R; ++r) acc += p.proj[(size_t)t * PLD + C_GLR + r] * w[r * GLA_HK + j];
    float g = -softplusf_(-acc) / 16.0f;
    p.galpha[gid] = expf(g);
}
DEVFN void b_gla_rec(const P& p, const int l, long gid) {
    int e = (int)(gid % GLA_DV); int h = (int)((gid / GLA_DV) % GLA_H); int b = (int)(gid / (GLA_DV * GLA_H));
    float st[GLA_DK];
#pragma unroll
    for (int d = 0; d < GLA_DK; ++d) st[d] = 0.f;
    const float scale = 1.0f / sqrtf((float)GLA_DK);
    for (int s = 0; s < S; ++s) {
        size_t t = (size_t)b * S + s;
        const float* pr = p.proj + t * PLD;
        const float* al = p.galpha + t * GLA_HK + h * GLA_DK;
        float v = pr[C_GV + h * GLA_DV + e];
        float o = 0.f;
#pragma unroll
        for (int d = 0; d < GLA_DK; ++d) {
            st[d] = al[d] * st[d] + pr[C_GK + h * GLA_DK + d] * v;
            o += (pr[C_GQ + h * GLA_DK + d] * scale) * st[d];
        }
        p.goraw[t * GW + h * GLA_DV + e] = o;
    }
}
DEVFN void b_gla_norm(const P& p, const int l, long gid) {
    long t = gid / GLA_H; int h = (int)(gid % GLA_H);
    const float* o = p.goraw + (size_t)t * GW + h * GLA_DV; float s = 0.f;
    for (int e = 0; e < GLA_DV; ++e) s += o[e] * o[e];
    p.gorstd[gid] = 1.0f / sqrtf(s / (float)GLA_DV + RMS_EPS);
}
DEVFN void b_gla_out(const P& p, const int l, long gid) {
    long t = gid / GW; int c = (int)(gid % GW); int h = c / GLA_DV;
    float o = p.goraw[gid] * p.gorstd[t * GLA_H + h] * p.gla_norm_g[(size_t)l * GW + c];
    float og = p.proj[(size_t)t * PLD + C_GOG + c];
    p.mixedb[(size_t)t * D + GW + c] = f2bf(o * (og * sigmoidf_(og)));
}

DEVFN void b_s5_pre(const P& p, const int l, long gid) {
    int g = (int)(gid / S5_P);
    float step = expf(p.s5_log_step[(size_t)l * S5_G + g]);
    float lr = p.s5_a_re[(size_t)l * S5_GP + gid], li = p.s5_a_im[(size_t)l * S5_GP + gid];
    float mag = expf(lr * step), ang = li * step;
    float are = mag * cosf(ang), aim = mag * sinf(ang);
    float den = lr * lr + li * li;
    float fre = ((are - 1.0f) * lr + aim * li) / den;
    float fim = (aim * lr - (are - 1.0f) * li) / den;
    p.s5abar[gid * 2] = are; p.s5abar[gid * 2 + 1] = aim;
    for (int h = 0; h < S5_HG; ++h) {
        float br = p.s5_b_re[((size_t)l * S5_GP + gid) * S5_HG + h], bi = p.s5_b_im[((size_t)l * S5_GP + gid) * S5_HG + h];
        p.s5bb[(gid * S5_HG + h) * 2] = fre * br - fim * bi;
        p.s5bb[(gid * S5_HG + h) * 2 + 1] = fre * bi + fim * br;
    }
}
DEVFN void b_s5_scan(const P& p, const int l, long gid) {
    int gp = (int)(gid % S5_GP); int b = (int)(gid / S5_GP); int g = gp / S5_P;
    float are = p.s5abar[gp * 2], aim = p.s5abar[gp * 2 + 1];
    float xr = 0.f, xi = 0.f;
    float* XR = p.big; float* XI = p.big + (size_t)T * S5_GP;
    float bbr[S5_HG], bbi[S5_HG];
#pragma unroll
    for (int h = 0; h < S5_HG; ++h) { bbr[h] = p.s5bb[((size_t)gp * S5_HG + h) * 2]; bbi[h] = p.s5bb[((size_t)gp * S5_HG + h) * 2 + 1]; }
    for (int s = 0; s < S; ++s) {
        size_t t = (size_t)b * S + s;
        const float* u = p.proj + t * PLD + C_S5U + g * S5_HG;
        float bur = 0.f, bui = 0.f;
#pragma unroll
        for (int h = 0; h < S5_HG; ++h) { float uv = u[h]; bur += uv * bbr[h]; bui += uv * bbi[h]; }
        float nr = are * xr - aim * xi + bur, ni = are * xi + aim * xr + bui;
        xr = nr; xi = ni;
        XR[t * S5_GP + gp] = xr; XI[t * S5_GP + gp] = xi;
    }
}
DEVFN void b_s5_y(const P& p, const int l, long gid) {
    long t = gid / GW; int c = (int)(gid % GW); int g = c / S5_HG, h = c % S5_HG;
    const float* XR = p.big + (size_t)t * S5_GP + g * S5_P; const float* XI = p.big + (size_t)T * S5_GP + (size_t)t * S5_GP + g * S5_P;
    const float* cr = p.s5_c_re + (((size_t)l * S5_G + g) * S5_HG + h) * S5_P;
    const float* ci = p.s5_c_im + (((size_t)l * S5_G + g) * S5_HG + h) * S5_P;
    float y = 0.f;
    for (int q = 0; q < S5_P; ++q) y += XR[q] * cr[q] - XI[q] * ci[q];
    y += p.s5_d[(size_t)l * GW + c] * p.proj[(size_t)t * PLD + C_S5U + c];
    const float zz = gelu_tanhf_(y); p.s5z[gid] = zz; p.s5zb[gid] = f2bf(zz);
}
DEVFN void b_s5_out(const P& p, const int l, long gid) {
    long t = gid / GW; int c = (int)(gid % GW);
    float z = p.s5z[gid];
    p.mixedb[(size_t)t * D + 2 * GW + c] = f2bf(z * sigmoidf_(p.s5lin[gid] + p.s5_b_glu[(size_t)l * GW + c]));
}

DEVFN void b_mb_rope(const P& p, const int l, long gid) {
    long t = gid / GW; int c = (int)(gid % GW); int dd = c % MB_HD; int pos = (int)(t % S);
    const float* q = p.proj + (size_t)t * PLD + C_MQ; const float* k = p.proj + (size_t)t * PLD + C_MK;
    float qv = q[c], kv = k[c];
    if (dd < MB_ROPE) {
        const int half = MB_ROPE / 2; int i = dd % half;
        float inv = powf(500000.0f, -(float)i / (float)half);
        float ang = (float)pos * inv; float cs = cosf(ang), sn = sinf(ang);
        if (dd < half) { qv = q[c] * cs - q[c + half] * sn; kv = k[c] * cs - k[c + half] * sn; }
        else { qv = q[c] * cs + q[c - half] * sn; kv = k[c] * cs + k[c - half] * sn; }
    }
    p.mqr[gid] = qv; p.mkr[gid] = kv;
}
DEVFN void b_mb_kmean(const P& p, const int l, long gid) {
    int d = (int)(gid % MB_HD); int j = (int)((gid / MB_HD) % MB_NB); int h = (int)((gid / (MB_HD * MB_NB)) % MB_H); int b = (int)(gid / ((long)MB_HD * MB_NB * MB_H));
    float s = 0.f;
    for (int k = 0; k < MB_BLK; ++k) s += p.mkr[((size_t)b * S + j * MB_BLK + k) * GW + h * MB_HD + d];
    p.mkmean[gid] = s / (float)MB_BLK;
}
DEVFN void b_mb_sel(const P& p, const int l, long gid) {
    int s = (int)(gid % S); int h = (int)((gid / S) % MB_H); int b = (int)(gid / ((long)S * MB_H));
    int own = s / MB_BLK;
    const float* q = p.mqr + ((size_t)b * S + s) * GW + h * MB_HD;
    float v0 = -INFINITY, v1 = -INFINITY, v2 = -INFINITY; int i0 = -1, i1 = -1, i2 = -1;
    for (int j = 0; j < own; ++j) {
        const float* km = p.mkmean + (((size_t)b * MB_H + h) * MB_NB + j) * MB_HD;
        float g = 0.f;
        for (int d = 0; d < MB_HD; ++d) g += q[d] * km[d];
        if (i0 < 0 || g > v0) { v2 = v1; i2 = i1; v1 = v0; i1 = i0; v0 = g; i0 = j; }
        else if (i1 < 0 || g > v1) { v2 = v1; i2 = i1; v1 = g; i1 = j; }
        else if (i2 < 0 || g > v2) { v2 = g; i2 = j; }
    }
    p.midx[gid * 3] = i0; p.midx[gid * 3 + 1] = i1; p.midx[gid * 3 + 2] = i2;
}
DEVFN void b_mb_score(const P& p, const int l, long gid) {
    int slot = (int)(gid % MB_SLOTS); long qi = gid / MB_SLOTS;
    int s = (int)(qi % S); int h = (int)((qi / S) % MB_H); int b = (int)(qi / ((long)S * MB_H));
    int m = slot / MB_BLK, kk = slot % MB_BLK; int own = s / MB_BLK;
    int blk = (m < 3) ? p.midx[qi * 3 + m] : own;
    float sc = -INFINITY;
    if (blk >= 0) {
        int kp = blk * MB_BLK + kk;
        if (m < 3 || kp <= s) {
            const float* q = p.mqr + ((size_t)b * S + s) * GW + h * MB_HD;
            const float* k = p.mkr + ((size_t)b * S + kp) * GW + h * MB_HD;
            float a = 0.f;
            for (int d = 0; d < MB_HD; ++d) a += q[d] * k[d];
            sc = a * (1.0f / sqrtf((float)MB_HD));
        }
    }
    p.big[gid] = sc;
}
DEVFN void b_mb_stat(const P& p, const int l, long gid) {
    float* sc = p.big + (size_t)gid * MB_SLOTS;
    float mx = -INFINITY;
    for (int i = 0; i < MB_SLOTS; ++i) mx = fmaxf(mx, sc[i]);
    float sum = 0.f;
    for (int i = 0; i < MB_SLOTS; ++i) sum += expf(sc[i] - mx);
    float inv = 1.0f / sum;
    for (int i = 0; i < MB_SLOTS; ++i) sc[i] = expf(sc[i] - mx) * inv;
}
DEVFN void b_mb_out(const P& p, const int l, long gid) {
    long t = gid / GW; int c = (int)(gid % GW); int h = c / MB_HD; int b = (int)(t / S), s = (int)(t % S);
    long qi = ((long)b * MB_H + h) * S + s; int own = s / MB_BLK;
    const float* pr = p.big + (size_t)qi * MB_SLOTS;
    float o = 0.f;
    for (int m = 0; m < 4; ++m) {
        int blk = (m < 3) ? p.midx[qi * 3 + m] : own;
        if (blk < 0) continue;
        for (int kk = 0; kk < MB_BLK; ++kk) {
            float pv = pr[m * MB_BLK + kk];
            if (pv != 0.f) o += pv * p.proj[((size_t)b * S + blk * MB_BLK + kk) * PLD + C_MV + c];
        }
    }
    p.mixedb[(size_t)t * D + 3 * GW + c] = f2bf(o);
}

DEVFN void b_pe_score(const P& p, const int l, long gid) {
    int k = (int)(gid % PE_NK); long r = gid / PE_NK; int hc = (int)(r % (PE_H * 2)); long t = r / (PE_H * 2);
    const float* q = p.pq + (size_t)t * PE_QW + hc * PE_DH;
    const float* sk = p.peer_subkeys + (((size_t)l * PE_H * 2 + hc) * PE_NK + k) * PE_DH;
    float a = 0.f;
    for (int d = 0; d < PE_DH; ++d) a += q[d] * sk[d];
    p.ps[gid] = a;
}
DEVFN void b_pe_top1(const P& p, const int l, long gid) {
    const float* s = p.ps + (size_t)gid * PE_NK;
    float pvv = INFINITY; int pii = -1;
    for (int r = 0; r < PE_K; ++r) {
        float bv = -INFINITY; int bi = -1;
        for (int i = 0; i < PE_NK; ++i) {
            float v = s[i];
            bool after = (v < pvv) || (v == pvv && i > pii);
            if (after && (bi < 0 || v > bv)) { bv = v; bi = i; }
        }
        p.pv[gid * PE_K + r] = bv; p.pi[gid * PE_K + r] = bi; pvv = bv; pii = bi;
    }
}
DEVFN void b_pe_top2(const P& p, const int l, long gid) {
    const float* v1 = p.pv + (size_t)(gid * 2) * PE_K; const float* v2 = p.pv + (size_t)(gid * 2 + 1) * PE_K;
    const int* i1 = p.pi + (size_t)(gid * 2) * PE_K; const int* i2 = p.pi + (size_t)(gid * 2 + 1) * PE_K;
    float pvv = INFINITY; int pii = -1; float mx = 0.f;
    for (int r = 0; r < PE_K; ++r) {
        float bv = -INFINITY; int bi = -1;
        for (int i = 0; i < PE_K * PE_K; ++i) {
            float v = v1[i / PE_K] + v2[i % PE_K];
            bool after = (v < pvv) || (v == pvv && i > pii);
            if (after && (bi < 0 || v > bv)) { bv = v; bi = i; }
        }
        p.psc[gid * PE_K + r] = bv; p.pexp[gid * PE_K + r] = i1[bi / PE_K] * PE_NK + i2[bi % PE_K]; pvv = bv; pii = bi;
        if (r == 0) mx = bv;
    }
    float sum = 0.f;
    for (int r = 0; r < PE_K; ++r) sum += expf(p.psc[gid * PE_K + r] - mx);
    for (int r = 0; r < PE_K; ++r) p.pgate[gid * PE_K + r] = expf(p.psc[gid * PE_K + r] - mx) / sum;
}
DEVFN void b_scatter(const P& p, const int l, long gid) {
    bf16_t* g = p.G + (size_t)gid * PE_E;
    for (int k = 0; k < PE_HK; ++k) { const int e = p.pexp[gid * PE_HK + k]; g[e] = f2bf(bf2f(g[e]) + p.pgate[gid * PE_HK + k]); }
}

DEVFN void b_cvt(const float* __restrict__ src, bf16_t* __restrict__ dst, const float* __restrict__ g, int K, long gid) {
    const size_t i = (size_t)gid * 8; const int k = (int)(i % K);
    const float4 a = *(const float4*)(src + i), b = *(const float4*)(src + i + 4);
    const float4 ga = *(const float4*)(g + k), gb = *(const float4*)(g + k + 4);
    *(uint4*)(dst + i) = make_uint4(pack2bf(a.x * ga.x, a.y * ga.y), pack2bf(a.z * ga.z, a.w * ga.w), pack2bf(b.x * gb.x, b.y * gb.y), pack2bf(b.z * gb.z, b.w * gb.w));
}
struct EpiF32S {
    static constexpr bool PERM = false, AFTER_DRAIN = false;
    float* C; const float* sumsq; const float* R; int ldc; int ldr;
    __device__ __forceinline__ void operator()(const pg8::f32x4 (&acc)[2][2][4][2], const pg8::Unit& u, int wr, int wc, int fr, int fq) const {
        const int row0 = u.pm * 256 + wr * 64 + fr, col0 = u.pn * 256 + wc * 32 + 4 * fq;
#pragma unroll
        for (int ai = 0; ai < 2; ++ai)
#pragma unroll
            for (int m = 0; m < 4; ++m) {
                const int row = row0 + ai * 128 + m * 16;
                const float sc = sumsq ? 1.0f / sqrtf(sumsq[row] * (1.0f / (float)D) + RMS_EPS) : 1.0f;
#pragma unroll
                for (int bj = 0; bj < 2; ++bj)
#pragma unroll
                    for (int n = 0; n < 2; ++n) {
                        const int col = col0 + bj * 128 + n * 16;
                        pg8::f32x4 v = acc[ai][bj][m][n] * sc;
                        if (R) v += *(const pg8::f32x4*)(R + (size_t)row * ldr + col);
                        *(pg8::f32x4*)(C + (size_t)row * ldc + col) = v;
                    }
            }
    }
};
struct EpiPeer1 {
    static constexpr bool PERM = true, AFTER_DRAIN = false;
    bf16_t* Pm; const bf16_t* G; const float* sumsq; int ld; int pad;
    __device__ __forceinline__ void operator()(const pg8::f32x4 (&acc)[2][2][4][2], const pg8::Unit& u, int wr, int wc, int fr, int fq) const {
        const int row0 = u.pm * 256 + wr * 64 + fr, col0 = u.pn * 256 + wc * 32 + 8 * fq;
#pragma unroll
        for (int ai = 0; ai < 2; ++ai)
#pragma unroll
            for (int m = 0; m < 4; ++m) {
                const int row = row0 + ai * 128 + m * 16;
                const float sc = 1.0f / sqrtf(sumsq[row] * (1.0f / (float)D) + RMS_EPS);
#pragma unroll
                for (int bj = 0; bj < 2; ++bj) {
                    const size_t o = (size_t)row * ld + col0 + bj * 128;
                    const pg8::u32x4 gw = *(const pg8::u32x4*)(G + o);
                    const pg8::f32x4 v0 = acc[ai][bj][m][0] * sc, v1 = acc[ai][bj][m][1] * sc;
                    const pg8::f32x2 a = pg8::gelu_pk((pg8::f32x2){v0[0], v0[1]}), b = pg8::gelu_pk((pg8::f32x2){v0[2], v0[3]}),
                                     c = pg8::gelu_pk((pg8::f32x2){v1[0], v1[1]}), d = pg8::gelu_pk((pg8::f32x2){v1[2], v1[3]});
                    pg8::u32x4 w;
                    w.x = pack2bf(a.x * __uint_as_float(gw.x << 16), a.y * __uint_as_float(gw.x & 0xffff0000u));
                    w.y = pack2bf(b.x * __uint_as_float(gw.y << 16), b.y * __uint_as_float(gw.y & 0xffff0000u));
                    w.z = pack2bf(c.x * __uint_as_float(gw.z << 16), c.y * __uint_as_float(gw.z & 0xffff0000u));
                    w.w = pack2bf(d.x * __uint_as_float(gw.w << 16), d.y * __uint_as_float(gw.w & 0xffff0000u));
                    *(pg8::u32x4*)(Pm + o) = w;
                }
            }
    }
};

#define XB_TMO      128
#define XB_XCNT(j)  (256  + 64 * (j))
#define XB_XSUB(j)  (1280 + 64 * (j))
#define XB_XGEN(j)  (2304 + 64 * (j))
#define XB_TOP      3328
#define XB_TOPGEN   3392
#define XCD_BAR_WORDS 3456
#define XB_SPIN_CAP (1u << 18)
#define LAS __attribute__((address_space(3)))

__device__ __forceinline__ unsigned xb_ld(unsigned* p)              { return __hip_atomic_load(p, __ATOMIC_RELAXED, __HIP_MEMORY_SCOPE_AGENT); }
__device__ __forceinline__ unsigned xb_add(unsigned* p, unsigned v) { return __hip_atomic_fetch_add(p, v, __ATOMIC_RELAXED, __HIP_MEMORY_SCOPE_AGENT); }
__device__ __forceinline__ unsigned xb_xcc_id() { return (unsigned)__builtin_amdgcn_s_getreg((3 << 11) | 20) & 0xFu; }
#define XB_SPIN(cond, bar) do { unsigned _sp = 0; while (cond) { __builtin_amdgcn_s_sleep(1); \
    if ((++_sp & 255u) == 0u) { if (xb_ld(&(bar)[XB_TMO])) break; if (_sp > XB_SPIN_CAP) { atomicAdd(&(bar)[XB_TMO], 1u); break; } } } } while (0)

struct XcdBarrier {
    unsigned* bar; unsigned x;
    volatile LAS unsigned* st;
};

__device__ __forceinline__ XcdBarrier xcd_barrier_post(unsigned* bar, volatile LAS unsigned* st) {
    XcdBarrier b; b.bar = bar; b.x = xb_xcc_id(); b.st = st;
    if (threadIdx.x == 0) (void)xb_add(&bar[XB_XCNT(b.x)], 1u);
    return b;
}
__device__ __forceinline__ void xcd_barrier_complete(unsigned* bar, unsigned x, unsigned& nloc, unsigned& nx) {
    const unsigned G = gridDim.x * gridDim.y * gridDim.z;
    unsigned sum, cnt, mine, sp = 0u;
    for (;;) {
        sum = 0u; cnt = 0u; mine = 0u;
#pragma unroll
        for (unsigned j = 0; j < 16; ++j) { const unsigned c = xb_ld(&bar[XB_XCNT(j)]); sum += c; cnt += (c > 0u) ? 1u : 0u; mine = (j == x) ? c : mine; }
        if (sum == G) break;
        __builtin_amdgcn_s_sleep(1);
        if ((++sp & 255u) == 0u) { if (xb_ld(&bar[XB_TMO])) break; if (sp > XB_SPIN_CAP) { atomicAdd(&bar[XB_TMO], 1u); break; } }
    }
    nloc = mine > 0u ? mine : 1u; nx = cnt > 0u ? cnt : 1u;
}

__device__ __forceinline__ void xcd_barrier(const XcdBarrier& b) {
    asm volatile("s_waitcnt vmcnt(0)" ::: "memory");
    __syncthreads();
    if (threadIdx.x == 0) {
        unsigned* bar = b.bar;
        __builtin_amdgcn_s_waitcnt(0);
        unsigned nloc = b.st[0], nx = b.st[1];
        if (nloc == 0u) { xcd_barrier_complete(bar, b.x, nloc, nx); b.st[0] = nloc; b.st[1] = nx; }
        const unsigned old = xb_add(&bar[XB_XSUB(b.x)], 1u);
        const unsigned gen = old / nloc;
        if (old + 1u == (gen + 1u) * nloc) {
            __builtin_amdgcn_fence(__ATOMIC_RELEASE, "agent");
            asm volatile("s_waitcnt vmcnt(0)" ::: "memory");
            const unsigned og = xb_add(&bar[XB_TOP], 1u);
            const unsigned tg = og / nx;
            if (og + 1u == (tg + 1u) * nx) xb_add(&bar[XB_TOPGEN], 1u);
            else XB_SPIN(xb_ld(&bar[XB_TOPGEN]) == tg, bar);
            __builtin_amdgcn_fence(__ATOMIC_ACQUIRE, "agent");
            xb_add(&bar[XB_XGEN(b.x)], 1u);
            asm volatile("s_waitcnt vmcnt(0)" ::: "memory");
        } else {
            XB_SPIN(xb_ld(&bar[XB_XGEN(b.x)]) == gen, bar);
            __builtin_amdgcn_fence(__ATOMIC_ACQUIRE, "agent");
            asm volatile("s_waitcnt vmcnt(0)" ::: "memory");
        }
    }
    __syncthreads();
}


DEVFN int tid_fresh() { int t = threadIdx.x; asm volatile("" : "+v"(t)); return t; }
#define VLOOP(n, rot, wrot, call) do { const long _n = (long)(n); const int _G = (int)gridDim.x; const int _vb = (int)((blockIdx.x + _G - ((rot) % _G)) % _G); const int _t = tid_fresh(); \
    for (long _w = (long)(((_t >> 6) + (wrot)) & 7) * _G + _vb; _w * 64 < _n; _w += 8L * _G) { const long gid = _w * 64 + (_t & 63); if (gid < _n) { call; } } } while (0)

DEVFN void ph_cvt_t(LAS float* tile, const float* __restrict__ src, int N, int K, bf16_t* __restrict__ dst, int Npad, const float* __restrict__ g) {
    const int tid = tid_fresh(), ntn = Npad / 128, ntk = K / 64, ty = tid >> 5, tx = tid & 31, nn = tid >> 2, ks = (tid & 3) * 16;
    for (int ti = blockIdx.x; ti < ntn * ntk; ti += gridDim.x) {
        const int n0 = (ti % ntn) * 128, k0 = (ti / ntn) * 64;
#pragma unroll
        for (int r = 0; r < 4; ++r) {
            const int kk = ty + 16 * r, n = n0 + tx * 4;
            float4 v = make_float4(0.f, 0.f, 0.f, 0.f);
            if (n + 4 <= N) v = *(const float4*)(src + (size_t)(k0 + kk) * N + n);
            const float gg = g ? g[k0 + kk] : 1.0f;
            tile[kk * 129 + tx * 4 + 0] = v.x * gg; tile[kk * 129 + tx * 4 + 1] = v.y * gg; tile[kk * 129 + tx * 4 + 2] = v.z * gg; tile[kk * 129 + tx * 4 + 3] = v.w * gg;
        }
        __syncthreads();
        unsigned w[8];
#pragma unroll
        for (int i = 0; i < 8; ++i) w[i] = pack2bf(tile[(ks + 2 * i) * 129 + nn], tile[(ks + 2 * i + 1) * 129 + nn]);
        uint4* d = (uint4*)(dst + (size_t)(n0 + nn) * K + k0 + ks);
        d[0] = make_uint4(w[0], w[1], w[2], w[3]); d[1] = make_uint4(w[4], w[5], w[6], w[7]);
        __syncthreads();
    }
}
DEVFN void ph_xprep(const float* __restrict__ x, bf16_t* __restrict__ xb, float* __restrict__ sumsq) {
    const int tid = tid_fresh(), lane = tid & 63;
    for (int row = (int)(tid >> 6) * (int)gridDim.x + (int)blockIdx.x; row < T; row += 8 * (int)gridDim.x) {
        const float4* r = (const float4*)(x + (size_t)row * D); uint2* o = (uint2*)(xb + (size_t)row * D); float s = 0.f;
        for (int i = lane; i < D / 4; i += 64) { const float4 v = r[i]; s += v.x * v.x + v.y * v.y + v.z * v.z + v.w * v.w; o[i] = make_uint2(pack2bf(v.x, v.y), pack2bf(v.z, v.w)); }
        for (int off = 32; off >= 1; off >>= 1) s += __shfl_xor(s, off);
        if (lane == 0) sumsq[row] = s;
    }
}
DEVFN void ph_final(const float* __restrict__ x, const float* __restrict__ g, float* __restrict__ out) {
    const int tid = tid_fresh(), lane = tid & 63;
    for (int row = (int)(tid >> 6) * (int)gridDim.x + (int)blockIdx.x; row < T; row += 8 * (int)gridDim.x) {
        const float4* r = (const float4*)(x + (size_t)row * D); float4* o = (float4*)(out + (size_t)row * D); float s = 0.f;
        for (int i = lane; i < D / 4; i += 64) { const float4 v = r[i]; s += v.x * v.x + v.y * v.y + v.z * v.z + v.w * v.w; }
        for (int off = 32; off >= 1; off >>= 1) s += __shfl_xor(s, off);
        const float rs = 1.0f / sqrtf(s * (1.0f / (float)D) + RMS_EPS);
        for (int i = lane; i < D / 4; i += 64) { const float4 v = r[i]; const float4 gg = ((const float4*)g)[i]; o[i] = make_float4(v.x * rs * gg.x, v.y * rs * gg.y, v.z * rs * gg.z, v.w * rs * gg.w); }
    }
}
template <class Epi> DEVFN void ph_gemm(LAS unsigned char* lds, const bf16_t* A, const bf16_t* Bt, int M, int N, int K, const Epi& E) {
    asm volatile("" : "+s"(K), "+s"(M), "+s"(N));
    pg8::Gemm g; g.A = A; g.Bt = Bt; g.M = M; g.N = N; g.K = K;
    pg8::StaticOrder So; So.init(M, N, (int)gridDim.x, (int)blockIdx.x);
    pg8::gemm_phase<Epi, pg8::StaticOrder, false>(lds, g, So, E, nullptr);
}

#ifndef MK_LAUNCHES
#define MK_LAUNCHES 1
#endif
constexpr int NPH = 17, NPH_ALL = NL * NPH + 1;
constexpr int LDS_BYTES = pg8::STAGE_BYTES + 64;
struct Args { P p; unsigned* bar; int ph_lo, ph_hi, use_bar, pad; };

__global__ void __launch_bounds__(512, 2) fwd(Args a) {
    extern __shared__ __attribute__((aligned(16))) unsigned char lds_raw[];
    LAS unsigned char* lds = (LAS unsigned char*)lds_raw;
    volatile LAS unsigned* st = (volatile LAS unsigned*)(lds + pg8::STAGE_BYTES);
    if (threadIdx.x == 0) { st[0] = 0u; st[1] = 0u; st[2] = 0u; st[3] = 0u; }
    __syncthreads();
    XcdBarrier bar; bar.bar = a.bar; bar.x = 0; bar.st = st;
    if (a.use_bar) bar = xcd_barrier_post(a.bar, st);
    const P& p = a.p;
    const int lo = a.ph_lo, hi = a.ph_hi;
    LAS float* tile = (LAS float*)lds;
#define IN(k) (lo <= (k) && (k) < hi)
#define SEAM(k) do { if (IN((k) + 1)) xcd_barrier(bar); } while (0)
    for (int l = 0; l < NL; ++l) {
        const int b = l * NPH;
        const float* xin = (l == 0) ? p.x : p.xb;
        if (IN(b + 0)) {
            ph_cvt_t(tile, p.w_in + (size_t)l * D * INW, INW, D, p.WinT, PLD, p.norm1_g + (size_t)l * D);
            ph_cvt_t(tile, p.w_out + (size_t)l * D * D, D, D, p.WoutT, D, nullptr);
            ph_cvt_t(tile, p.peer_wq + (size_t)l * D * PE_QW, PE_QW, D, p.WqT, PE_QW, p.norm2_g + (size_t)l * D);
            ph_cvt_t(tile, p.s5_w_glu + (size_t)l * GW * GW, GW, GW, p.GluT, GW, nullptr);
            ph_cvt_t(tile, p.peer_v + (size_t)l * PE_E * D, D, PE_E, p.Vt, D, nullptr);
            VLOOP((long)PE_E * D / 8, 0, 0, b_cvt(p.peer_u + (size_t)l * PE_E * D, p.Ub, p.norm2_g + (size_t)l * D, D, gid));
            ph_xprep(xin, p.xbf, p.sumsq);
            SEAM(b + 0);
        }
        if (IN(b + 1)) { EpiF32S e; e.C = p.proj; e.sumsq = p.sumsq; e.R = nullptr; e.ldc = PLD; e.ldr = 0; ph_gemm(lds, p.xbf, p.WinT, T, PLD, D, e); SEAM(b + 1); }
        if (IN(b + 2)) {
            VLOOP((long)T * GW, 0, 0, b_lru_conv(p, l, gid)); VLOOP((long)T * GLA_HK, 0, 0, b_gla_g(p, l, gid)); VLOOP((long)S5_GP, 0, 0, b_s5_pre(p, l, gid)); VLOOP((long)T * GW, 0, 0, b_mb_rope(p, l, gid));
            SEAM(b + 2);
        }
        if (IN(b + 3)) {
            VLOOP((long)NB * GLA_H * GLA_DV, 0, 0, b_gla_rec(p, l, gid)); VLOOP((long)NB * S5_GP, 0, 1, b_s5_scan(p, l, gid));
            VLOOP((long)T * GW, 0, 2, b_lru_gate(p, l, gid)); VLOOP((long)NB * MB_H * MB_NB * MB_HD, 0, 3, b_mb_kmean(p, l, gid));
            SEAM(b + 3);
        }
        if (IN(b + 4)) {
            VLOOP((long)NB * GW, 0, 0, b_lru_scan(p, l, gid)); VLOOP((long)T * GW, 0, 1, b_s5_y(p, l, gid)); VLOOP((long)T * GLA_H, 0, 2, b_gla_norm(p, l, gid)); VLOOP((long)NB * MB_H * S, 0, 3, b_mb_sel(p, l, gid));
            SEAM(b + 4);
        }
        if (IN(b + 5)) {
            { EpiF32S e; e.C = p.s5lin; e.sumsq = nullptr; e.R = nullptr; e.ldc = GW; e.ldr = 0; ph_gemm(lds, p.s5zb, p.GluT, T, GW, GW, e); }
            VLOOP((long)T * GW, 0, 0, b_gla_out(p, l, gid)); VLOOP((long)NB * MB_H * S * MB_SLOTS, 0, 0, b_mb_score(p, l, gid));
            SEAM(b + 5);
        }
        if (IN(b + 6)) { VLOOP((long)T * GW, 0, 0, b_s5_out(p, l, gid)); VLOOP((long)NB * MB_H * S, 0, 0, b_mb_stat(p, l, gid)); SEAM(b + 6); }
        if (IN(b + 7)) { VLOOP((long)T * GW, 0, 0, b_mb_out(p, l, gid)); SEAM(b + 7); }
        if (IN(b + 8)) { EpiF32S e; e.C = p.xa; e.sumsq = nullptr; e.R = xin; e.ldc = D; e.ldr = D; ph_gemm(lds, p.mixedb, p.WoutT, T, D, D, e); SEAM(b + 8); }
        if (IN(b + 9)) {
            ph_xprep(p.xa, p.xbf, p.sumsq);
            VLOOP((long)T * PE_E / 8, 0, 0, ((uint4*)p.G)[gid] = make_uint4(0u, 0u, 0u, 0u));
            SEAM(b + 9);
        }
        if (IN(b + 10)) { EpiF32S e; e.C = p.pq; e.sumsq = p.sumsq; e.R = nullptr; e.ldc = PE_QW; e.ldr = 0; ph_gemm(lds, p.xbf, p.WqT, T, PE_QW, D, e); SEAM(b + 10); }
        if (IN(b + 11)) { VLOOP((long)T * PE_H * 2 * PE_NK, 0, 0, b_pe_score(p, l, gid)); SEAM(b + 11); }
        if (IN(b + 12)) { VLOOP((long)T * PE_H * 2, 0, 0, b_pe_top1(p, l, gid)); SEAM(b + 12); }
        if (IN(b + 13)) { VLOOP((long)T * PE_H, 0, 0, b_pe_top2(p, l, gid)); SEAM(b + 13); }
        if (IN(b + 14)) { VLOOP((long)T, 0, 0, b_scatter(p, l, gid)); SEAM(b + 14); }
        if (IN(b + 15)) { EpiPeer1 e; e.Pm = p.Pm; e.G = p.G; e.sumsq = p.sumsq; e.ld = PE_E; e.pad = 0; ph_gemm(lds, p.xbf, p.Ub, T, PE_E, D, e); SEAM(b + 15); }
        if (IN(b + 16)) { EpiF32S e; e.C = p.xb; e.sumsq = nullptr; e.R = p.xa; e.ldc = D; e.ldr = D; ph_gemm(lds, p.Pm, p.Vt, T, D, PE_E, e); SEAM(b + 16); }
    }
    if (IN(NL * NPH)) ph_final(p.xb, p.final_norm_g, p.out);
#undef IN
#undef SEAM
}

extern "C" void kernel_launch(void* const* d_in, const int* in_sizes, int n_in, void* d_out, int out_size, void* d_ws, size_t ws_size, hipStream_t stream) {
    Args a{};
    P& p = a.p;
    const float** ins = (const float**)&p.x;
    for (int i = 0; i < 30; ++i) ins[i] = (const float*)d_in[i];
    p.out = (float*)d_out;
    float* w = (float*)d_ws; size_t off = 0;
    auto take = [&](size_t nfl) { float* r = w + off; off += (nfl + 63) & ~(size_t)63; return r; };
    a.bar = (unsigned*)take(XCD_BAR_WORDS);
    p.xa = take((size_t)T * D); p.xb = take((size_t)T * D); p.proj = take((size_t)T * PLD); p.rstd = take(T); p.sumsq = take(T);
    p.xbf = (bf16_t*)take((size_t)T * D / 2); p.mixedb = (bf16_t*)take((size_t)T * D / 2);
    p.lxc = take((size_t)T * GW); p.lA = take((size_t)T * GW); p.lB = take((size_t)T * GW);
    p.galpha = take((size_t)T * GLA_HK); p.goraw = take((size_t)T * GW); p.gorstd = take((size_t)T * GLA_H);
    p.s5abar = take((size_t)S5_GP * 2); p.s5bb = take((size_t)S5_GP * S5_HG * 2); p.s5z = take((size_t)T * GW); p.s5lin = take((size_t)T * GW); p.s5zb = (bf16_t*)take((size_t)T * GW / 2);
    p.mqr = take((size_t)T * GW); p.mkr = take((size_t)T * GW); p.mkmean = take((size_t)NB * MB_H * MB_NB * MB_HD); p.mstat = take(64);
    p.midx = (int*)take((size_t)NB * MB_H * S * 3);
    size_t bigsz = (size_t)T * S5_GP * 2; { size_t b2 = (size_t)NB * MB_H * S * MB_SLOTS; if (b2 > bigsz) bigsz = b2; size_t b3 = (size_t)T * PE_E / 2; if (b3 > bigsz) bigsz = b3; }
    p.big = take(bigsz);
    p.pq = take((size_t)T * PE_QW); p.ps = take((size_t)T * PE_H * 2 * PE_NK); p.pv = take((size_t)T * PE_H * 2 * PE_K); p.pi = (int*)take((size_t)T * PE_H * 2 * PE_K);
    p.psc = take((size_t)T * PE_HK); p.pexp = (int*)take((size_t)T * PE_HK); p.pgate = take((size_t)T * PE_HK); p.pw = take(64);
    p.WinT = (bf16_t*)take((size_t)PLD * D / 2); p.WoutT = (bf16_t*)take((size_t)D * D / 2); p.WqT = (bf16_t*)take((size_t)PE_QW * D / 2); p.GluT = (bf16_t*)take((size_t)GW * GW / 2);
    p.Ub = (bf16_t*)take((size_t)PE_E * D / 2); p.Vt = (bf16_t*)take((size_t)PE_E * D / 2);
    p.G = (bf16_t*)p.proj;
    p.Pm = (bf16_t*)p.big;
    static_assert((size_t)PE_E * 2 <= (size_t)PLD * 4, "G alias");
    if (off * sizeof(float) > ws_size) return;
    static int grid = 0;
    if (grid == 0) {
        int dev = 0, cus = 0;
        if (hipGetDevice(&dev) != hipSuccess || hipDeviceGetAttribute(&cus, hipDeviceAttributeMultiprocessorCount, dev) != hipSuccess) { grid = -1; return; }
        if (hipFuncSetAttribute((const void*)fwd, hipFuncAttributeMaxDynamicSharedMemorySize, LDS_BYTES) != hipSuccess) { grid = -1; return; }
        int per_cu = 0;
        if (hipOccupancyMaxActiveBlocksPerMultiprocessor(&per_cu, (const void*)fwd, 512, LDS_BYTES) != hipSuccess || per_cu < 1) { (void)hipGetLastError(); }
        grid = cus;
    }
    if (grid < 0) return;
    (void)hipMemsetAsync(a.bar, 0, XCD_BAR_WORDS * sizeof(unsigned), stream);
#if MK_LAUNCHES == 1
    a.ph_lo = 0; a.ph_hi = NPH_ALL; a.use_bar = 1;
    hipLaunchKernelGGL(fwd, dim3(grid), dim3(512), LDS_BYTES, stream, a);
#else
    for (int ph = 0; ph < NPH_ALL; ++ph) { a.ph_lo = ph; a.ph_hi = ph + 1; a.use_bar = 0; hipLaunchKernelGGL(fwd, dim3(grid), dim3(512), LDS_BYTES, stream, a); }
#endif
}
```

```cpp
#include <hip/hip_runtime.h>
#define DEVFN __device__ __forceinline__
#include <math.h>
namespace pg8 {
#define PG8_LAS __attribute__((address_space(3)))
typedef unsigned short bf16_t;
typedef short bf16x8 __attribute__((ext_vector_type(8)));
typedef float f32x4 __attribute__((ext_vector_type(4)));
typedef unsigned u32x4 __attribute__((ext_vector_type(4)));
constexpr int BM = 256, BK = 64, HALF = 128, HTB = HALF * BK * 2  , STAGE_BYTES = 8 * HTB, NXCD = 8, WGM = 8;

__host__ __device__ __forceinline__ int lds_byte(int r, int c) { const int st = (r >> 4) * 2 + (c >> 5), rr = r & 15, cc = c & 31, ob = rr * 64 + cc * 2; return st * 1024 + (ob ^ (((ob >> 9) & 1) << 5)); }
__host__ __device__ __forceinline__ void stage_rc(int b, int& R, int& C) { const int st = b / 1024, sb = b % 1024, swz = sb ^ (((sb >> 9) & 1) << 5); R = (st >> 1) * 16 + swz / 64; C = (st & 1) * 32 + (swz % 64) / 2; }
__host__ __device__ __forceinline__ int perm32(int rho) { const int n = rho >> 4, i = rho & 15; return 8 * (i >> 2) + 4 * n + (i & 3); }

struct Unit { int pm, pn; };
struct Gemm { const bf16_t* A; const bf16_t* Bt; int M, N, K; };

struct StaticOrder {
    int nM, nN, nwg, G, c, wgm;
    __host__ __device__ void init(int M, int N, int G_, int c_, int wgm_ = WGM) { nM = M / BM; nN = N / BM; nwg = nM * nN; G = G_; c = c_; wgm = wgm_; }
    __host__ __device__ bool next(int i, Unit& u) const {
        const long L = (long)i * G + c; if (L >= nwg) return false;
        int wgid = (int)L; { const int q = nwg / NXCD, r = nwg % NXCD, xcd = wgid % NXCD, off = wgid / NXCD; wgid = (xcd < r ? xcd * (q + 1) : r * (q + 1) + (xcd - r) * q) + off; }
        const int nig = wgm * nN, gid = wgid / nig, fm = gid * wgm, gsz = (nM - fm) < wgm ? (nM - fm) : wgm;
        u.pm = fm + ((wgid % nig) % gsz); u.pn = (wgid % nig) / gsz; return true;
    }
    __device__ __forceinline__ void a_ready(const Unit&) const {}
    __device__ __forceinline__ void done(const Unit&) const {}
};
struct CountedOrder : StaticOrder {
    const unsigned* ready; unsigned need; unsigned* tmo;
    __device__ __forceinline__ void a_ready(const Unit& u) const {
        if (threadIdx.x < 64) {
            const unsigned long long t0 = __builtin_amdgcn_s_memrealtime(); unsigned polls = 0;
            while ((unsigned)__builtin_amdgcn_readfirstlane(__hip_atomic_load(ready + 64 * u.pm, __ATOMIC_RELAXED, __HIP_MEMORY_SCOPE_AGENT)) < need) {
                if ((++polls & 255u) == 0u && __builtin_amdgcn_readfirstlane(__hip_atomic_load(tmo, __ATOMIC_RELAXED, __HIP_MEMORY_SCOPE_AGENT)) != 0u) break;
                if (__builtin_amdgcn_s_memrealtime() - t0 > 2000000ull) {
                    if (threadIdx.x == 0) { unsigned expect = 0u; __hip_atomic_compare_exchange_strong(tmo + 1, &expect, 0x600u | (unsigned)(u.pm & 0xff), __ATOMIC_RELAXED, __ATOMIC_RELAXED, __HIP_MEMORY_SCOPE_AGENT); __hip_atomic_store(tmo, 1u, __ATOMIC_RELAXED, __HIP_MEMORY_SCOPE_AGENT); }
                    break; }
                __builtin_amdgcn_s_sleep(2); }
            __builtin_amdgcn_fence(__ATOMIC_ACQUIRE, "agent");
            asm volatile("s_waitcnt vmcnt(0)" ::: "memory");
        }
#if !defined(BROKEN_HOOK_NO_BARRIER)
        asm volatile("" ::: "memory"); __builtin_amdgcn_s_barrier(); asm volatile("" ::: "memory");
#endif
    }
};

__device__ __forceinline__ unsigned cvt_pk_bf16(float lo, float hi) { unsigned r; asm volatile("v_cvt_pk_bf16_f32 %0, %1, %2" : "=v"(r) : "v"(lo), "v"(hi)); return r; }
typedef float f32x2 __attribute__((ext_vector_type(2)));
__device__ __forceinline__ f32x2 gelu_pk(f32x2 v) {
    const f32x2 av = __builtin_elementwise_abs(v), d = av * 0.2316418882f + 1.0f;
    f32x2 t; t.x = __builtin_amdgcn_rcpf(d.x); t.y = __builtin_amdgcn_rcpf(d.y);
    f32x2 q = t * 0.5307027145f + (-0.7265760135f); q = q * t + 0.7107068705f; q = q * t + (-0.142248368f); q = q * t + 0.127414796f; q = q * t;
    const f32x2 s = (v * v) * (-0.72134752044f);
    f32x2 e; e.x = __builtin_amdgcn_exp2f(s.x); e.y = __builtin_amdgcn_exp2f(s.y);
    const f32x2 m = v * (q * e), r = v - m;
    f32x2 o; o.x = v.x < 0.f ? m.x : r.x; o.y = v.y < 0.f ? m.y : r.y; return o;
}

struct EpiF32 {
    static constexpr bool PERM = false, AFTER_DRAIN = false;
    float* C; int ldc; const float* bias;
    __device__ __forceinline__ void operator()(const f32x4 (&acc)[2][2][4][2], const Unit& u, int wr, int wc, int fr, int fq) const {
        const int row0 = u.pm * BM + wr * 64 + fr, col0 = u.pn * BM + wc * 32 + 4 * fq;
        f32x4 bv[2][2];
#pragma unroll
        for (int bj = 0; bj < 2; ++bj)
#pragma unroll
            for (int n = 0; n < 2; ++n) bv[bj][n] = bias ? *(const f32x4*)(bias + col0 + bj * HALF + n * 16) : (f32x4){0.f, 0.f, 0.f, 0.f};
#pragma unroll
        for (int ai = 0; ai < 2; ++ai)
#pragma unroll
            for (int m = 0; m < 4; ++m) { float* rowp = C + (size_t)(row0 + ai * HALF + m * 16) * ldc + col0;
#pragma unroll
                for (int bj = 0; bj < 2; ++bj)
#pragma unroll
                    for (int n = 0; n < 2; ++n) *(f32x4*)(rowp + bj * HALF + n * 16) = acc[ai][bj][m][n] + bv[bj][n]; }
    }
};
template <int ACT  > struct EpiBf16 {
    static constexpr bool PERM = true, AFTER_DRAIN = false;
    bf16_t* O; int ldc; const float* bias; int split_cols; size_t split_stride;
    __device__ __forceinline__ void operator()(const f32x4 (&acc)[2][2][4][2], const Unit& u, int wr, int wc, int fr, int fq) const {
        const int row0 = u.pm * BM + wr * 64 + fr; int colt = u.pn * BM; bf16_t* base = O;
        if (split_cols) { const int t = colt / split_cols; base += (size_t)t * split_stride; colt -= t * split_cols; }
        const int col0 = colt + wc * 32 + 8 * fq, bcol0 = u.pn * BM + wc * 32 + 8 * fq;
        f32x4 bv[2][2];
#pragma unroll
        for (int bj = 0; bj < 2; ++bj)
#pragma unroll
            for (int n = 0; n < 2; ++n) bv[bj][n] = bias ? *(const f32x4*)(bias + bcol0 + bj * HALF + 4 * n) : (f32x4){0.f, 0.f, 0.f, 0.f};
#pragma unroll
        for (int ai = 0; ai < 2; ++ai)
#pragma unroll
            for (int m = 0; m < 4; ++m) { bf16_t* rowp = base + (size_t)(row0 + ai * HALF + m * 16) * ldc + col0;
#pragma unroll
                for (int bj = 0; bj < 2; ++bj) { f32x4 v0 = acc[ai][bj][m][0] + bv[bj][0], v1 = acc[ai][bj][m][1] + bv[bj][1];
                    if (ACT == 1) { f32x2 a = gelu_pk((f32x2){v0[0], v0[1]}), b = gelu_pk((f32x2){v0[2], v0[3]}), c = gelu_pk((f32x2){v1[0], v1[1]}), d = gelu_pk((f32x2){v1[2], v1[3]});
                        v0 = (f32x4){a.x, a.y, b.x, b.y}; v1 = (f32x4){c.x, c.y, d.x, d.y}; }
                    if (ACT == 2) {
#pragma unroll
                        for (int j = 0; j < 4; ++j) { v0[j] = 0.5f * v0[j] * (1.0f + erff(v0[j] * 0.70710678f)); v1[j] = 0.5f * v1[j] * (1.0f + erff(v1[j] * 0.70710678f)); } }
                    u32x4 w; w.x = cvt_pk_bf16(v0[0], v0[1]); w.y = cvt_pk_bf16(v0[2], v0[3]); w.z = cvt_pk_bf16(v1[0], v1[1]); w.w = cvt_pk_bf16(v1[2], v1[3]);
                    *(u32x4*)(rowp + bj * HALF) = w; } }
    }
};
template <class Epi, class Sched, bool ALIGN_EPI = false, bool SP2 = false, bool F8 = false>
__device__ __forceinline__ void gemm_phase(PG8_LAS unsigned char* lds, const Gemm g, const Sched& S, const Epi& E) {
    int tid_ = threadIdx.x; asm volatile("" : "+v"(tid_));
    const int tid = tid_, wid = __builtin_amdgcn_readfirstlane(tid >> 6), lane = tid & 63, wr = wid >> 2, wc = wid & 3, fr = lane & 15, fq = lane >> 4;
    const int K = g.K, nt = K / BK;
    unsigned voffA[2], voffB[2];
#pragma unroll
    for (int i = 0; i < 2; ++i) { int R, C; stage_rc(tid * 16 + i * 8192, R, C); const int Rb = Epi::PERM ? ((R & ~31) + perm32(R & 31)) : R;
        voffA[i] = (unsigned)(R * K + C) * 2u; voffB[i] = (unsigned)(Rb * K + C) * 2u; }
    const size_t kstep = (size_t)(BK * 2);
    const size_t hstep = (size_t)HALF * K * 2;
    const size_t tstep = 2 * hstep;
    const unsigned ldsw = (unsigned)wid * 1024u;
    const int aoff = lds_byte(wr * 64 + fr, fq * 8), boff = lds_byte(wc * 32 + fr, fq * 8);
#define PG8_SA(b, h) (((b) * 2 + (h)) * HTB)
#define PG8_SB(b, h) ((4 + (b) * 2 + (h)) * HTB)
#define PG8_STAGE(bufoff, gbase, voff) do { _Pragma("unroll") for (int _i = 0; _i < 2; ++_i) \
        __builtin_amdgcn_global_load_lds((const unsigned*)((const char*)(gbase) + (voff)[_i]), (PG8_LAS unsigned*)(lds + (bufoff) + ldsw + _i * 8192), 16, 0, 0); } while (0)
#define PG8_LDA(dst, b, h) do { if constexpr (F8) { _Pragma("unroll") for (int m = 0; m < 4; ++m) { const i32x4_ lo_ = *(const PG8_LAS i32x4_*)(lds + PG8_SA(b, h) + aoff + m * 2048), hi_ = *(const PG8_LAS i32x4_*)(lds + PG8_SA(b, h) + aoff + m * 2048 + 1024); \
        dst##8[m] = __builtin_shufflevector(lo_, hi_, 0, 1, 2, 3, 4, 5, 6, 7); } } \
    else { _Pragma("unroll") for (int m = 0; m < 4; ++m) _Pragma("unroll") for (int k = 0; k < 2; ++k) dst[m][k] = *(const PG8_LAS bf16x8*)(lds + PG8_SA(b, h) + aoff + m * 2048 + k * 1024); } } while (0)
#define PG8_LDB(dst, b, h) do { if constexpr (F8) { _Pragma("unroll") for (int n = 0; n < 2; ++n) { const i32x4_ lo_ = *(const PG8_LAS i32x4_*)(lds + PG8_SB(b, h) + boff + n * 2048), hi_ = *(const PG8_LAS i32x4_*)(lds + PG8_SB(b, h) + boff + n * 2048 + 1024); \
        dst##8[n] = __builtin_shufflevector(lo_, hi_, 0, 1, 2, 3, 4, 5, 6, 7); } } \
    else { _Pragma("unroll") for (int n = 0; n < 2; ++n) _Pragma("unroll") for (int k = 0; k < 2; ++k) dst[n][k] = *(const PG8_LAS bf16x8*)(lds + PG8_SB(b, h) + boff + n * 2048 + k * 1024); } } while (0)
#define PG8_MMA(ai, bj, At, Bt) do { __builtin_amdgcn_s_setprio(1); _Pragma("unroll") for (int m = 0; m < 4; ++m) _Pragma("unroll") for (int n = 0; n < 2; ++n) { \
        if constexpr (F8) asm volatile("v_mfma_f32_16x16x128_f8f6f4 %0, %1, %2, %0" : "+v"(acc[ai][bj][m][n]) : "v"(Bt##8[n]), "v"(At##8[m]));     \
        else { _Pragma("unroll") for (int k = 0; k < 2; ++k) acc[ai][bj][m][n] = __builtin_amdgcn_mfma_f32_16x16x32_bf16(Bt[n][k], At[m][k], acc[ai][bj][m][n], 0, 0, 0); } } \
        __builtin_amdgcn_s_setprio(0); } while (0)
#define PG8_WAIT_V(n) asm volatile("s_waitcnt vmcnt(" #n ")" ::: "memory")
#define PG8_WAIT_L(n) asm volatile("s_waitcnt lgkmcnt(" #n ")" ::: "memory")
#define PG8_BAR __builtin_amdgcn_s_barrier()
#define PG8_SCHED __builtin_amdgcn_sched_barrier(0)
    Unit cur, nxt; int ui = 0;
    if (!S.next(0, cur)) return;
    f32x4 acc[2][2][4][2];
    float zf_ = 0.f; asm volatile("" : "+v"(zf_));
#pragma unroll
    for (int a = 0; a < 2; ++a)
#pragma unroll
        for (int b = 0; b < 2; ++b)
#pragma unroll
            for (int m = 0; m < 4; ++m)
#pragma unroll
                for (int n = 0; n < 2; ++n) acc[a][b][m][n] = (f32x4){zf_, zf_, zf_, zf_};
    typedef int i32x4_ __attribute__((ext_vector_type(4))); typedef int i32x8_ __attribute__((ext_vector_type(8)));
    bf16x8 At[4][2], B0[2][2], B1[2][2]; i32x8_ At8[4], B08[2], B18[2];
    const char* cA = (const char*)g.A + (size_t)cur.pm * tstep; const char* cB = (const char*)g.Bt + (size_t)cur.pn * tstep;
    S.a_ready(cur);
    if constexpr (SP2) {
        PG8_STAGE(PG8_SB(0, 0), cB, voffB); PG8_STAGE(PG8_SB(0, 1), cB + hstep, voffB); PG8_STAGE(PG8_SA(0, 0), cA, voffA); PG8_STAGE(PG8_SA(0, 1), cA + hstep, voffA);
        if (wr == 1) PG8_BAR;
        PG8_WAIT_V(2); PG8_BAR;
        PG8_STAGE(PG8_SB(1, 0), cB + kstep, voffB); PG8_STAGE(PG8_SA(1, 0), cA + kstep, voffA); PG8_STAGE(PG8_SB(1, 1), cB + hstep + kstep, voffB);
        PG8_WAIT_V(6); PG8_BAR;
    } else {
        PG8_STAGE(PG8_SB(0, 0), cB, voffB); PG8_STAGE(PG8_SA(0, 0), cA, voffA); PG8_STAGE(PG8_SB(0, 1), cB + hstep, voffB); PG8_STAGE(PG8_SA(0, 1), cA + hstep, voffA);
        if (wr == 1) PG8_BAR;
        PG8_WAIT_V(4); PG8_BAR;
        PG8_STAGE(PG8_SB(1, 0), cB + kstep, voffB); PG8_STAGE(PG8_SA(1, 0), cA + kstep, voffA); PG8_STAGE(PG8_SB(1, 1), cB + hstep + kstep, voffB);
        PG8_WAIT_V(6); PG8_BAR;
    }
    for (;;) {
        const bool has_next = S.next(ui + 1, nxt);
        const char* nA = has_next ? (const char*)g.A + (size_t)nxt.pm * tstep : cA; const char* nB = has_next ? (const char*)g.Bt + (size_t)nxt.pn * tstep : cB;
        for (int t = 0; t < nt; t += 2) {
            const bool last = (t == nt - 2);
            const char* a1 = cA + (size_t)(t + 1) * kstep;
            const char* a2 = last ? nA : cA + (size_t)(t + 2) * kstep; const char* b2 = last ? nB : cB + (size_t)(t + 2) * kstep;
            const char* a3 = a2 + kstep; const char* b3 = b2 + kstep;
            if (last && has_next) S.a_ready(nxt);
            if constexpr (SP2) {
            PG8_LDB(B0, 0, 0); PG8_LDB(B1, 0, 1); PG8_SCHED; PG8_LDA(At, 0, 0); PG8_STAGE(PG8_SA(1, 1), a1 + hstep, voffA);
            PG8_WAIT_V(8); PG8_WAIT_L(0); PG8_BAR; PG8_MMA(0, 0, At, B0); PG8_MMA(0, 1, At, B1); PG8_BAR; PG8_SCHED;
            PG8_LDA(At, 0, 1); PG8_STAGE(PG8_SB(0, 0), b2, voffB); PG8_STAGE(PG8_SB(0, 1), b2 + hstep, voffB); PG8_STAGE(PG8_SA(0, 0), a2, voffA);
            PG8_WAIT_V(8); PG8_WAIT_L(0); PG8_BAR; PG8_MMA(1, 0, At, B0); PG8_MMA(1, 1, At, B1); PG8_BAR; PG8_SCHED;
            PG8_LDB(B0, 1, 0); PG8_LDB(B1, 1, 1); PG8_SCHED; PG8_LDA(At, 1, 0); PG8_STAGE(PG8_SA(0, 1), a2 + hstep, voffA);
            PG8_WAIT_V(8); PG8_WAIT_L(0); PG8_BAR; PG8_MMA(0, 0, At, B0); PG8_MMA(0, 1, At, B1); PG8_BAR; PG8_SCHED;
            PG8_LDA(At, 1, 1); PG8_STAGE(PG8_SB(1, 0), b3, voffB); PG8_STAGE(PG8_SB(1, 1), b3 + hstep, voffB); PG8_STAGE(PG8_SA(1, 0), a3, voffA);
            PG8_WAIT_V(8); PG8_WAIT_L(0); PG8_BAR; PG8_MMA(1, 0, At, B0); PG8_MMA(1, 1, At, B1); PG8_BAR; PG8_SCHED;
            } else {
            PG8_LDB(B0, 0, 0); PG8_SCHED; PG8_LDA(At, 0, 0); PG8_STAGE(PG8_SA(1, 1), a1 + hstep, voffA);
            PG8_WAIT_L(8); PG8_BAR; PG8_WAIT_L(0); PG8_MMA(0, 0, At, B0); PG8_BAR; PG8_SCHED;
            PG8_LDB(B1, 0, 1); PG8_STAGE(PG8_SB(0, 0), b2, voffB);
            PG8_BAR; PG8_WAIT_L(0); PG8_MMA(0, 1, At, B1); PG8_BAR;
            PG8_LDA(At, 0, 1); PG8_STAGE(PG8_SA(0, 0), a2, voffA);
            PG8_BAR; PG8_WAIT_L(0); PG8_MMA(1, 0, At, B0); PG8_BAR; PG8_SCHED;
            PG8_STAGE(PG8_SB(0, 1), b2 + hstep, voffB);
            PG8_WAIT_V(6); PG8_BAR; PG8_MMA(1, 1, At, B1); PG8_BAR;
            PG8_LDB(B0, 1, 0); PG8_SCHED; PG8_LDA(At, 1, 0); PG8_STAGE(PG8_SA(0, 1), a2 + hstep, voffA);
            PG8_WAIT_L(8); PG8_BAR; PG8_WAIT_L(0); PG8_MMA(0, 0, At, B0); PG8_BAR; PG8_SCHED;
            PG8_LDB(B1, 1, 1); PG8_STAGE(PG8_SB(1, 0), b3, voffB);
            PG8_BAR; PG8_WAIT_L(0); PG8_MMA(0, 1, At, B1); PG8_BAR;
            PG8_LDA(At, 1, 1); PG8_STAGE(PG8_SA(1, 0), a3, voffA);
            PG8_BAR; PG8_WAIT_L(0); PG8_MMA(1, 0, At, B0); PG8_BAR; PG8_SCHED;
            PG8_STAGE(PG8_SB(1, 1), b3 + hstep, voffB);
            PG8_WAIT_V(6); PG8_BAR; PG8_MMA(1, 1, At, B1); PG8_BAR;
            }
        }
        if constexpr (ALIGN_EPI) { if (wr == 0) PG8_BAR; }
        if constexpr (F8) asm volatile("s_nop 15\n\ts_nop 15" ::: "memory");
        if constexpr (!Epi::AFTER_DRAIN) { E(acc, cur, wr, wc, fr, fq); S.done(cur); }
        if (!has_next) break;
        asm volatile("" : "+v"(zf_));
#pragma unroll
        for (int a = 0; a < 2; ++a)
#pragma unroll
            for (int b = 0; b < 2; ++b)
#pragma unroll
                for (int m = 0; m < 4; ++m)
#pragma unroll
                    for (int n = 0; n < 2; ++n) acc[a][b][m][n] = (f32x4){zf_, zf_, zf_, zf_};
        cur = nxt; cA = nA; cB = nB; ++ui;
        if constexpr (ALIGN_EPI) { if (wr == 1) PG8_BAR; }
    }
    PG8_WAIT_V(0);
    if constexpr (!ALIGN_EPI) { if (wr == 0) PG8_BAR; }
    PG8_BAR;
    if constexpr (Epi::AFTER_DRAIN) { E.fused(acc, cur, wr, wc, fr, fq, lds, wid, lane); S.done(cur); }
#undef PG8_SA
#undef PG8_SB
#undef PG8_STAGE
#undef PG8_LDA
#undef PG8_LDB
#undef PG8_MMA
#undef PG8_WAIT_V
#undef PG8_WAIT_L
#undef PG8_BAR
#undef PG8_SCHED
}
}


#ifndef CFG_D_MODEL
#define CFG_D_MODEL 4096
#define CFG_SEQ 4096
#define CFG_S5_STATE 64
#define CFG_MOBA_BLOCK 256
#define CFG_PEER_NKEYS 128
#define CFG_PEER_DKEY 256
#define CFG_PEER_TOPK 16
#endif
constexpr int D = CFG_D_MODEL, NB = 2, S = CFG_SEQ, T = NB * S, NL = 2;
constexpr int GW = D / 4;
constexpr int LRU_NBLK = 8, LRU_BLK = GW / LRU_NBLK;
constexpr int GLA_H = 4, GLA_DV = GW / GLA_H, GLA_DK = GLA_DV / 2, GLA_R = 16, GLA_HK = GLA_H * GLA_DK;
constexpr int S5_HG = 16, S5_G = GW / S5_HG, S5_P = CFG_S5_STATE, S5_GP = S5_G * S5_P;
constexpr int MB_H = 8, MB_HD = GW / MB_H, MB_BLK = CFG_MOBA_BLOCK, MB_NB = S / MB_BLK, MB_ROPE = MB_HD / 4, MB_SLOTS = 4 * MB_BLK;
constexpr int PE_H = 8, PE_NK = CFG_PEER_NKEYS, PE_E = PE_NK * PE_NK, PE_DK = CFG_PEER_DKEY, PE_DH = PE_DK / 2, PE_K = CFG_PEER_TOPK, PE_HK = PE_H * PE_K, PE_QW = PE_H * PE_DK;
constexpr int C_LRUX = 0, C_LRUG = GW, C_GQ = 2 * GW, C_GK = C_GQ + GLA_HK, C_GV = C_GK + GLA_HK, C_GLR = C_GV + GW, C_GOG = C_GLR + GLA_R,
              C_S5U = C_GOG + GW, C_MQ = C_S5U + GW, C_MK = C_MQ + GW, C_MV = C_MK + GW, INW = C_MV + GW, PLD = ((INW + 255) / 256) * 256;
constexpr float RMS_EPS = 1e-6f;
typedef unsigned short bf16_t;
#define LAS __attribute__((address_space(3)))
DEVFN int tid_fresh() { int t = threadIdx.x; asm volatile("" : "+v"(t)); return t; }
DEVFN int bid_fresh() { int b = blockIdx.x; asm volatile("" : "+s"(b)); return b; }
typedef unsigned u32x4v __attribute__((ext_vector_type(4)));
typedef float f32x4z_ __attribute__((ext_vector_type(4)));
DEVFN f32x4z_ zero4() { float z = 0.f; asm volatile("" : "+v"(z)); return (f32x4z_){z, z, z, z}; }
DEVFN u32x4v zero4u() { unsigned z = 0u; asm volatile("" : "+v"(z)); return (u32x4v){z, z, z, z}; }
DEVFN unsigned dpp_rowmax_u(unsigned v) {
    v = max(v, (unsigned)__builtin_amdgcn_update_dpp(0, (int)v, 0xB1, 0xF, 0xF, false));
    v = max(v, (unsigned)__builtin_amdgcn_update_dpp(0, (int)v, 0x4E, 0xF, 0xF, false));
    v = max(v, (unsigned)__builtin_amdgcn_update_dpp(0, (int)v, 0x141, 0xF, 0xF, false));
    v = max(v, (unsigned)__builtin_amdgcn_update_dpp(0, (int)v, 0x140, 0xF, 0xF, false));
    return v;
}
DEVFN float dpp_rowmax_f(float v) {
    v = fmaxf(v, __int_as_float(__builtin_amdgcn_update_dpp(0, __float_as_int(v), 0xB1, 0xF, 0xF, false)));
    v = fmaxf(v, __int_as_float(__builtin_amdgcn_update_dpp(0, __float_as_int(v), 0x4E, 0xF, 0xF, false)));
    v = fmaxf(v, __int_as_float(__builtin_amdgcn_update_dpp(0, __float_as_int(v), 0x141, 0xF, 0xF, false)));
    v = fmaxf(v, __int_as_float(__builtin_amdgcn_update_dpp(0, __float_as_int(v), 0x140, 0xF, 0xF, false)));
    return v;
}
DEVFN unsigned xrow16_max_u(unsigned v) { const auto r = __builtin_amdgcn_permlane16_swap(v, v, false, false); return max((unsigned)r[0], (unsigned)r[1]); }
DEVFN unsigned xrow32_max_u(unsigned v) { const auto r = __builtin_amdgcn_permlane32_swap(v, v, false, false); return max((unsigned)r[0], (unsigned)r[1]); }
DEVFN float xrow16_max_f(float v) { const auto r = __builtin_amdgcn_permlane16_swap(__float_as_uint(v), __float_as_uint(v), false, false); return fmaxf(__uint_as_float(r[0]), __uint_as_float(r[1])); }
DEVFN float xrow32_max_f(float v) { const auto r = __builtin_amdgcn_permlane32_swap(__float_as_uint(v), __float_as_uint(v), false, false); return fmaxf(__uint_as_float(r[0]), __uint_as_float(r[1])); }
DEVFN float dpp_rowsum_f(float v) {
    v += __int_as_float(__builtin_amdgcn_update_dpp(0, __float_as_int(v), 0xB1, 0xF, 0xF, false));
    v += __int_as_float(__builtin_amdgcn_update_dpp(0, __float_as_int(v), 0x4E, 0xF, 0xF, false));
    v += __int_as_float(__builtin_amdgcn_update_dpp(0, __float_as_int(v), 0x141, 0xF, 0xF, false));
    v += __int_as_float(__builtin_amdgcn_update_dpp(0, __float_as_int(v), 0x140, 0xF, 0xF, false));
    return v;
}
typedef unsigned u32x2v __attribute__((ext_vector_type(2)));
DEVFN bf16_t f2bf(float f) { unsigned u = __float_as_uint(f); u += 0x7FFFu + ((u >> 16) & 1u); return (bf16_t)(u >> 16); }
DEVFN float bf2f(bf16_t b) { return __uint_as_float(((unsigned)b) << 16); }
DEVFN unsigned pack2bf(float lo, float hi) { return (unsigned)f2bf(lo) | ((unsigned)f2bf(hi) << 16); }

struct WsLayout { size_t bar, sumsq, ssp, pli, plg, xbf, xq8, mixedb, pjb, gbc, gdec, gUT, gvT, gsp, galias_end, lA, lB, lxcb, lruW, s5bb, s5pw, s5el, s5kt, s5we, s5mc, s5zb, mkmean, midx, mqrb, mkrb, mvt, pqb, skb, P8, WinT, WoutT, WqT, GluT, U8, Vt8, end; };
constexpr WsLayout make_ws_layout() {
    WsLayout L{}; size_t o = 0;
#define WSF(name, bytes) L.name = o; o += (((size_t)(bytes)) + 255) & ~(size_t)255;
    WSF(bar, 3456 * 4) WSF(sumsq, (size_t)T * 4) WSF(ssp, (size_t)T * 64 * 4) WSF(pli, (size_t)T * PE_HK * 4) WSF(plg, (size_t)T * PE_HK * 4) WSF(xbf, (size_t)T * D * 2) WSF(xq8, (size_t)T * D) WSF(mixedb, (size_t)T * D * 2)
    WSF(pjb, (size_t)T * PLD * 2) WSF(gbc, (size_t)NB * GLA_H * (S / 64) * 64 * GLA_DK * 4) WSF(gdec, (size_t)NB * GLA_H * (S / 64) * GLA_DK * 4) WSF(gUT, (size_t)NB * GLA_H * (S / 64) * GLA_DV * GLA_DK * 4)
    WSF(gvT, (size_t)NB * GLA_H * (S / 64) * GLA_DV * 64 * 2) WSF(gsp, (size_t)NB * GLA_H * (S / 64) * GLA_DV * GLA_DK * 2) WSF(galias_end, 0)
    WSF(lA, (size_t)T * GW * 4) WSF(lB, (size_t)T * GW * 4) WSF(lxcb, (size_t)T * GW * 2) WSF(lruW, (size_t)2 * GW * GW * 2)
    WSF(s5bb, (size_t)S5_GP * S5_HG * 2 * 4) WSF(s5pw, (size_t)S5_GP * 65 * 2 * 4) WSF(s5el, (size_t)NB * S5_G * (S / 64) * 2 * S5_P * 4)
    WSF(s5kt, (size_t)S5_G * 64 * 256 * 2) WSF(s5we, (size_t)S5_G * 2 * S5_P * 64 * S5_HG * 2) WSF(s5mc, (size_t)S5_G * 64 * S5_HG * 2 * S5_P * 2) WSF(s5zb, (size_t)T * GW * 2)
    WSF(mkmean, (size_t)NB * MB_H * MB_NB * MB_HD * 4) WSF(midx, (size_t)NB * MB_H * S * 4) WSF(mqrb, (size_t)T * GW * 2) WSF(mkrb, (size_t)T * GW * 2) WSF(mvt, (size_t)T * GW * 2)
    WSF(pqb, (size_t)T * PE_QW * 2) WSF(skb, (size_t)PE_H * 2 * PE_NK * PE_DH * 2) WSF(P8, (size_t)T * PE_E)
    WSF(WinT, (size_t)PLD * D * 2) WSF(WoutT, (size_t)D * D * 2) WSF(WqT, (size_t)PE_QW * D * 2) WSF(GluT, (size_t)GW * GW * 2) WSF(U8, (size_t)PE_E * D) WSF(Vt8, (size_t)PE_E * D)
#undef WSF
    L.end = o; return L;
}
constexpr WsLayout WSL = make_ws_layout();
static_assert(WSL.galias_end - WSL.pjb >= (size_t)T * PE_E * 2, "the dense gate matrix must fit the region it aliases");
struct P {
    const float *x, *norm1_g, *w_in, *lru_conv_w, *lru_conv_b, *lru_wa, *lru_ba, *lru_wx, *lru_bx, *lru_lambda;
    const float *gla_wg2, *gla_bg, *gla_norm_g, *s5_a_re, *s5_a_im, *s5_log_step, *s5_b_re, *s5_b_im, *s5_c_re, *s5_c_im;
    const float *s5_d, *s5_w_glu, *s5_b_glu, *w_out, *norm2_g, *peer_wq, *peer_subkeys, *peer_u, *peer_v, *final_norm_g;
    float* out; unsigned char* ws;
#define WSA(type, name) __device__ __forceinline__ type* name() const { return (type*)(ws + WSL.name); }
    WSA(unsigned, bar) WSA(float, sumsq) WSA(float, ssp) WSA(int, pli) WSA(float, plg) WSA(bf16_t, xbf) WSA(unsigned char, xq8) WSA(bf16_t, mixedb)
    WSA(bf16_t, pjb) WSA(float, gbc) WSA(float, gdec) WSA(float, gUT) WSA(bf16_t, gvT) WSA(bf16_t, gsp)
    WSA(float, lA) WSA(float, lB) WSA(bf16_t, lxcb) WSA(bf16_t, lruW)
    WSA(float, s5bb) WSA(float, s5pw) WSA(float, s5el) WSA(bf16_t, s5kt) WSA(bf16_t, s5we) WSA(bf16_t, s5mc) WSA(bf16_t, s5zb)
    WSA(float, mkmean) WSA(int, midx) WSA(bf16_t, mqrb) WSA(bf16_t, mkrb) WSA(bf16_t, mvt)
    WSA(bf16_t, pqb) WSA(bf16_t, skb) WSA(unsigned char, P8)
    WSA(bf16_t, WinT) WSA(bf16_t, WoutT) WSA(bf16_t, WqT) WSA(bf16_t, GluT) WSA(unsigned char, U8) WSA(unsigned char, Vt8)
#undef WSA
    __device__ __forceinline__ bf16_t* A16() const { return (bf16_t*)(ws + WSL.pjb); }
};

DEVFN float fexp(float x) { return __builtin_amdgcn_exp2f(x * 1.4426950408889634f); }
DEVFN float sigmoidf_(float x) { return __builtin_amdgcn_rcpf(1.0f + fexp(-x)); }
DEVFN float softplusf_(float x) { return fmaxf(x, 0.0f) + 0.6931471805599453f * __builtin_amdgcn_logf(1.0f + fexp(-fabsf(x))); }
DEVFN float gelu_tanhf_(float x) { const float u = 0.7978845608028654f * (x + 0.044715f * x * x * x); return x * __builtin_amdgcn_rcpf(1.0f + fexp(-2.0f * u)); }
DEVFN float gelu_tanh_precise_(float x) { return 0.5f * x * (1.0f + tanhf(0.7978845608028654f * (x + 0.044715f * x * x * x))); }
DEVFN float gelu_erff_(float x) { return 0.5f * x * (1.0f + erff(x * 0.7071067811865476f)); }

typedef short bf16x8 __attribute__((ext_vector_type(8)));
typedef float f32x4 __attribute__((ext_vector_type(4)));
DEVFN unsigned pk2(float lo, float hi) { typedef float f2_ __attribute__((ext_vector_type(2))); typedef __bf16 b2_ __attribute__((ext_vector_type(2))); f2_ v = {lo, hi}; return __builtin_bit_cast(unsigned, __builtin_convertvector(v, b2_)); }
DEVFN float clamp8(float v) { return __builtin_amdgcn_fmed3f(v, -448.0f, 448.0f); }
DEVFN unsigned pk4f8(float a, float b, float c, float d) { int w = 0; w = __builtin_amdgcn_cvt_pk_fp8_f32(clamp8(a), clamp8(b), w, false); w = __builtin_amdgcn_cvt_pk_fp8_f32(clamp8(c), clamp8(d), w, true); return (unsigned)w; }
constexpr float F8S_X = 16.f, F8S_U = 1024.f, F8S_P = 32.f, F8S_V = 32.f;
constexpr int MBP_PITCH = 272;

DEVFN void ph_mb_prep(const P& p, LAS unsigned char* lds) {
    const int tid = tid_fresh(), row = tid >> 1, half = tid & 1;
    LAS float* part = (LAS float*)(lds + 256 * MBP_PITCH);
    for (int u = bid_fresh(); u < NB * MB_NB * MB_H; u += gridDim.x) {
        const int b = u / (MB_NB * MB_H), j = (u / MB_H) % MB_NB, h = u % MB_H;
        const int pos = j * MB_BLK + row; const size_t t = (size_t)b * S + pos;
        const int c0 = h * MB_HD + half * 64;
#pragma unroll
        for (int which = 0; which < 3; ++which) {
            const bf16_t* src = p.pjb() + t * PLD + (which == 0 ? C_MQ : (which == 1 ? C_MK : C_MV)) + c0;
#pragma unroll
            for (int c = 0; c < 2; ++c) {
                float v[32];
#pragma unroll
                for (int i = 0; i < 4; ++i) { const uint4 x = *(const uint4*)(src + c * 32 + i * 8); const unsigned xw[4] = {x.x, x.y, x.z, x.w};
#pragma unroll
                    for (int j = 0; j < 4; ++j) { v[8 * i + 2 * j] = __uint_as_float(xw[j] << 16); v[8 * i + 2 * j + 1] = __uint_as_float(xw[j] & 0xffff0000u); } }
                if (which < 2 && half == 0 && c == 0) {
#pragma unroll
                    for (int i = 0; i < 16; ++i) {
                        const float inv = powf(500000.0f, -(float)i / 16.0f);
                        const float ang = (float)pos * inv; const float cs = cosf(ang), sn = sinf(ang);
                        const float a = v[i], bb = v[i + 16];
                        v[i] = a * cs - bb * sn; v[i + 16] = bb * cs + a * sn;
                    }
                }
                unsigned w[16];
#pragma unroll
                for (int i = 0; i < 16; ++i) w[i] = pk2(v[2 * i], v[2 * i + 1]);
                if (which < 2) {
                    bf16_t* dst = (which == 0 ? p.mqrb() : p.mkrb()) + t * GW + c0 + c * 32;
#pragma unroll
                    for (int i = 0; i < 4; ++i) *(uint4*)(dst + i * 8) = make_uint4(w[4 * i], w[4 * i + 1], w[4 * i + 2], w[4 * i + 3]);
                }
                if (which >= 1) {
                    LAS unsigned char* d2 = lds + row * MBP_PITCH + (half * 64 + c * 32) * 2;
#pragma unroll
                    for (int i = 0; i < 4; ++i) *(LAS u32x4v*)(d2 + i * 16) = (u32x4v){w[4 * i], w[4 * i + 1], w[4 * i + 2], w[4 * i + 3]};
                }
            }
            if (which == 1) {
                __syncthreads();
                { const int d = tid & 127, pt = tid >> 7; float s = 0.f;
                  for (int r = 0; r < 64; ++r) s += bf2f(*(const LAS bf16_t*)(lds + (pt * 64 + r) * MBP_PITCH + d * 2));
                  part[pt * 128 + d] = s; }
                __syncthreads();
                if (tid < 128) p.mkmean()[(((size_t)b * MB_H + h) * MB_NB + j) * MB_HD + tid] = (part[tid] + part[128 + tid] + part[256 + tid] + part[384 + tid]) * (1.0f / (float)MB_BLK);
                __syncthreads();
            }
            if (which == 2) {
                __syncthreads();
                { const int d = tid & 127, seg = tid >> 7;
                  bf16_t* dst = p.mvt() + (((size_t)b * MB_H + h) * MB_HD + d) * S + j * MB_BLK + seg * 64;
#pragma unroll
                  for (int g = 0; g < 8; ++g) {
                      unsigned w[4];
#pragma unroll
                      for (int i = 0; i < 4; ++i) {
                          const unsigned lo = *(const LAS bf16_t*)(lds + (seg * 64 + g * 8 + 2 * i) * MBP_PITCH + d * 2), hi = *(const LAS bf16_t*)(lds + (seg * 64 + g * 8 + 2 * i + 1) * MBP_PITCH + d * 2);
                          w[i] = lo | (hi << 16);
                      }
                      *(uint4*)(dst + g * 8) = make_uint4(w[0], w[1], w[2], w[3]);
                  } }
                __syncthreads();
            }
        }
    }
}

DEVFN void ph_mb_sel(const P& p) {
    const int tid = tid_fresh(), lane = tid & 63;
    const int ntask = NB * MB_H * (S / 64);
    for (int task = bid_fresh() + (int)gridDim.x * (tid >> 6); task < ntask; task += 8 * (int)gridDim.x) {
        const int tk = __builtin_amdgcn_readfirstlane(task);
        const int sg = tk % (S / 64), h = (tk / (S / 64)) % MB_H, b = tk / ((S / 64) * MB_H);
        const int s = sg * 64 + lane, own = (sg * 64) / MB_BLK;
        const bf16_t* qp = p.mqrb() + ((size_t)b * S + s) * GW + h * MB_HD;
        unsigned qw[MB_HD / 2];
#pragma unroll
        for (int i = 0; i < MB_HD / 8; ++i) { const uint4 x = *(const uint4*)(qp + i * 8); qw[4 * i] = x.x; qw[4 * i + 1] = x.y; qw[4 * i + 2] = x.z; qw[4 * i + 3] = x.w; }
        float v0 = -INFINITY, v1 = -INFINITY, v2 = -INFINITY; int i0 = -1, i1 = -1, i2 = -1;
        for (int j = 0; j < own; ++j) {
            const float* km = p.mkmean() + (((size_t)b * MB_H + h) * MB_NB + j) * MB_HD;
            float g = 0.f;
#pragma unroll
            for (int d = 0; d < MB_HD / 2; ++d) { g += __uint_as_float(qw[d] << 16) * km[2 * d]; g += __uint_as_float(qw[d] & 0xffff0000u) * km[2 * d + 1]; }
            if (i0 < 0 || g > v0) { v2 = v1; i2 = i1; v1 = v0; i1 = i0; v0 = g; i0 = j; }
            else if (i1 < 0 || g > v1) { v2 = v1; i2 = i1; v1 = g; i1 = j; }
            else if (i2 < 0 || g > v2) { v2 = g; i2 = j; }
        }
        p.midx()[((size_t)b * MB_H + h) * S + s] = (i0 >= 0 ? (1 << i0) : 0) | (i1 >= 0 ? (1 << i1) : 0) | (i2 >= 0 ? (1 << i2) : 0);
    }
}

constexpr int MBA_KP = 272, MBA_VP = 144;
constexpr int MBA_KB = 64 * MBA_KP, MBA_VB = 128 * MBA_VP, MBA_BUF = MBA_KB + MBA_VB;
template <int NQT> DEVFN void mb_attn_unit(const P& p, LAS unsigned char* lds, const int b, const int h, const int i, const int qoff) {
    const int tid = tid_fresh(), w = __builtin_amdgcn_readfirstlane(tid >> 6), lane = tid & 63, l15 = lane & 15, quad = lane >> 4;
    const int q0 = i * MB_BLK + qoff + 16 * NQT * w;
    bf16x8 qf[NQT][4]; int msk[NQT], qpos[NQT];
#pragma unroll
    for (int qt = 0; qt < NQT; ++qt) {
        qpos[qt] = q0 + 16 * qt + l15;
        const bf16_t* qp = p.mqrb() + ((size_t)b * S + qpos[qt]) * GW + h * MB_HD + quad * 8;
#pragma unroll
        for (int ks = 0; ks < 4; ++ks) qf[qt][ks] = *(const bf16x8*)(qp + 32 * ks);
        msk[qt] = p.midx()[((size_t)b * MB_H + h) * S + qpos[qt]];
    }
    f32x4 o[8][NQT]; float mrow[NQT], lsum[NQT];
#pragma unroll
    for (int qt = 0; qt < NQT; ++qt) { mrow[qt] = -INFINITY; lsum[qt] = 0.f;
#pragma unroll
        for (int dt = 0; dt < 8; ++dt) o[dt][qt] = zero4(); }
    const float sc2 = 1.4426950408889634f / sqrtf((float)MB_HD);
    const bf16_t* kbase = p.mkrb() + (size_t)b * S * GW + h * MB_HD;
    const bf16_t* vbase = p.mvt() + ((size_t)b * MB_H + h) * MB_HD * S;
    const int ntile = (i + 1) * 4;
    const int kc0 = tid, kc1 = tid + 512;
    const int vc0 = tid, vc1 = tid + 512;
    u32x4v rk0, rk1, rv0, rv1;
#define MBA_LOAD(tau) do { const int _jj = (tau) >> 2, _j = (_jj == 0) ? i : _jj - 1, _key0 = _j * MB_BLK + ((tau) & 3) * 64; \
        rk0 = *(const u32x4v*)(kbase + (size_t)(_key0 + (kc0 >> 4)) * GW + (kc0 & 15) * 8); rk1 = *(const u32x4v*)(kbase + (size_t)(_key0 + (kc1 >> 4)) * GW + (kc1 & 15) * 8); \
        rv0 = *(const u32x4v*)(vbase + (size_t)(vc0 >> 3) * S + _key0 + (vc0 & 7) * 8); rv1 = *(const u32x4v*)(vbase + (size_t)(vc1 >> 3) * S + _key0 + (vc1 & 7) * 8); } while (0)
#define MBA_STORE(buf) do { LAS unsigned char* _kb = lds + (buf) * MBA_BUF; LAS unsigned char* _vb = _kb + MBA_KB; \
        *(LAS u32x4v*)(_kb + (kc0 >> 4) * MBA_KP + (kc0 & 15) * 16) = rk0; *(LAS u32x4v*)(_kb + (kc1 >> 4) * MBA_KP + (kc1 & 15) * 16) = rk1; \
        *(LAS u32x4v*)(_vb + (vc0 >> 3) * MBA_VP + (vc0 & 7) * 16) = rv0; *(LAS u32x4v*)(_vb + (vc1 >> 3) * MBA_VP + (vc1 & 7) * 16) = rv1; } while (0)
    MBA_LOAD(0); MBA_STORE(0);
    __syncthreads();
    for (int tau = 0; tau < ntile; ++tau) {
        if (tau + 1 < ntile) MBA_LOAD(tau + 1);
        const int jj = tau >> 2, j = (jj == 0) ? i : jj - 1, key0 = j * MB_BLK + (tau & 3) * 64; const bool own = (jj == 0);
        const LAS unsigned char* kb = lds + (tau & 1) * MBA_BUF; const LAS unsigned char* vb = kb + MBA_KB;
        f32x4 s[4][NQT];
#pragma unroll
        for (int kt = 0; kt < 4; ++kt) {
#pragma unroll
            for (int qt = 0; qt < NQT; ++qt) s[kt][qt] = zero4();
#pragma unroll
            for (int ks = 0; ks < 4; ++ks) {
                const bf16x8 kf = *(const LAS bf16x8*)(kb + (16 * kt + l15) * MBA_KP + 64 * ks + quad * 16);
#pragma unroll
                for (int qt = 0; qt < NQT; ++qt) s[kt][qt] = __builtin_amdgcn_mfma_f32_16x16x32_bf16(kf, qf[qt][ks], s[kt][qt], 0, 0, 0);
            }
        }
        bf16x8 pf[NQT][2];
#pragma unroll
        for (int qt = 0; qt < NQT; ++qt) {
            float tmax = -INFINITY;
            if (own) {
#pragma unroll
                for (int kt = 0; kt < 4; ++kt)
#pragma unroll
                    for (int e = 0; e < 4; ++e) {
                        const int key = key0 + 16 * kt + quad * 4 + e;
                        const float v = (key <= qpos[qt]) ? s[kt][qt][e] * sc2 : -INFINITY;
                        s[kt][qt][e] = v; tmax = fmaxf(tmax, v);
                    }
            } else {
                const float bias = ((msk[qt] >> j) & 1) ? 0.0f : -INFINITY;
#pragma unroll
                for (int kt = 0; kt < 4; ++kt)
#pragma unroll
                    for (int e = 0; e < 4; ++e) { const float v = __builtin_fmaf(s[kt][qt][e], sc2, bias); s[kt][qt][e] = v; tmax = fmaxf(tmax, v); }
            }
            tmax = xrow32_max_f(xrow16_max_f(tmax));
            const float mnew = fmaxf(mrow[qt], tmax);
            const float alpha = __builtin_amdgcn_exp2f(mrow[qt] - mnew);
            mrow[qt] = mnew;
            float ps = 0.f;
#pragma unroll
            for (int kt = 0; kt < 4; ++kt)
#pragma unroll
                for (int e = 0; e < 4; ++e) { const float pv = __builtin_amdgcn_exp2f(s[kt][qt][e] - mnew); s[kt][qt][e] = pv; ps += pv; }
            lsum[qt] = lsum[qt] * alpha + ps;
            if (__builtin_amdgcn_ballot_w64(alpha != 1.0f) != 0ull) {
#pragma unroll
                for (int dt = 0; dt < 8; ++dt) o[dt][qt] *= alpha;
            }
#pragma unroll
            for (int k2 = 0; k2 < 2; ++k2) {
                typedef unsigned u32x4_ __attribute__((ext_vector_type(4)));
                u32x4_ pw; pw.x = pk2(s[2 * k2][qt][0], s[2 * k2][qt][1]); pw.y = pk2(s[2 * k2][qt][2], s[2 * k2][qt][3]);
                pw.z = pk2(s[2 * k2 + 1][qt][0], s[2 * k2 + 1][qt][1]); pw.w = pk2(s[2 * k2 + 1][qt][2], s[2 * k2 + 1][qt][3]);
                pf[qt][k2] = __builtin_bit_cast(bf16x8, pw);
            }
        }
#pragma unroll
        for (int k2 = 0; k2 < 2; ++k2)
#pragma unroll
            for (int dt = 0; dt < 8; ++dt) {
                typedef unsigned u32x2_ __attribute__((ext_vector_type(2))); typedef unsigned u32x4_ __attribute__((ext_vector_type(4)));
                const LAS unsigned char* vp = vb + (16 * dt + l15) * MBA_VP + (32 * k2 + quad * 4) * 2;
                const u32x2_ lo = *(const LAS u32x2_*)vp, hi = *(const LAS u32x2_*)(vp + 32);
                u32x4_ vw; vw.x = lo.x; vw.y = lo.y; vw.z = hi.x; vw.w = hi.y;
                const bf16x8 vf = __builtin_bit_cast(bf16x8, vw);
#pragma unroll
                for (int qt = 0; qt < NQT; ++qt) o[dt][qt] = __builtin_amdgcn_mfma_f32_16x16x32_bf16(vf, pf[qt][k2], o[dt][qt], 0, 0, 0);
            }
        if (tau + 1 < ntile) MBA_STORE((tau + 1) & 1);
        __syncthreads();
    }
#undef MBA_LOAD
#undef MBA_STORE
#pragma unroll
    for (int qt = 0; qt < NQT; ++qt) {
        float lt = lsum[qt]; lt += __shfl_xor(lt, 16); lt += __shfl_xor(lt, 32);
        const float inv = 1.0f / lt;
        bf16_t* dst = p.mixedb() + ((size_t)b * S + qpos[qt]) * D + 3 * GW + h * MB_HD + quad * 4;
#pragma unroll
        for (int dt = 0; dt < 8; ++dt) { const f32x4 v = o[dt][qt] * inv; *(uint2*)(dst + 16 * dt) = make_uint2(pk2(v[0], v[1]), pk2(v[2], v[3])); }
    }
}
DEVFN void ph_mb_attn(const P& p, LAS unsigned char* lds) {
    for (int un = (int)((bid_fresh() + gridDim.x / 2) % gridDim.x); un < NB * MB_H * (MB_NB / 2) * 2; un += gridDim.x) {
        const int qh = un & 1, pr = un >> 1;
        const int b = pr / (MB_H * (MB_NB / 2)), h = (pr / (MB_NB / 2)) % MB_H, ip = pr % (MB_NB / 2);
        mb_attn_unit<1>(p, lds, b, h, MB_NB - 1 - ip, qh * 128);
        mb_attn_unit<1>(p, lds, b, h, ip, qh * 128);
    }
}

DEVFN void b_cvt8(const float* __restrict__ src, unsigned char* __restrict__ dst, const float* __restrict__ g, int K, float scale, long gid) {
    const size_t i = (size_t)gid * 8; const int k = (int)(i % K);
    const float4 a = *(const float4*)(src + i), b = *(const float4*)(src + i + 4);
    const float4 ga = *(const float4*)(g + k), gb = *(const float4*)(g + k + 4);
    *(uint2*)(dst + i) = make_uint2(pk4f8(a.x * ga.x * scale, a.y * ga.y * scale, a.z * ga.z * scale, a.w * ga.w * scale), pk4f8(b.x * gb.x * scale, b.y * gb.y * scale, b.z * gb.z * scale, b.w * gb.w * scale));
}
DEVFN void ph_cvt8_stream(const float* __restrict__ src, unsigned char* __restrict__ dst, const float* __restrict__ g, const int K, const float scale, const long n8) {
    const int tid = tid_fresh(); const long stride = (long)gridDim.x * 512;
    for (long base = (long)bid_fresh() * 512 + tid; base < n8; base += 4 * stride) {
        float4 a[4], b[4];
#pragma unroll
        for (int j = 0; j < 4; ++j) { const long gid = base + j * stride; if (gid < n8) { a[j] = *(const float4*)(src + gid * 8); b[j] = *(const float4*)(src + gid * 8 + 4); } }
#pragma unroll
        for (int j = 0; j < 4; ++j) { const long gid = base + j * stride; if (gid < n8) {
            const int k = (int)((gid * 8) % K); const float4 ga = *(const float4*)(g + k), gb = *(const float4*)(g + k + 4);
            *(uint2*)(dst + gid * 8) = make_uint2(pk4f8(a[j].x * ga.x * scale, a[j].y * ga.y * scale, a[j].z * ga.z * scale, a[j].w * ga.w * scale), pk4f8(b[j].x * gb.x * scale, b[j].y * gb.y * scale, b[j].z * gb.z * scale, b[j].w * gb.w * scale)); } }
    }
}
struct EpiF32S {
    static constexpr bool PERM = false, AFTER_DRAIN = false;
    float* C; const float* sumsq; const float* R; int ldc; int ldr;
    __device__ __forceinline__ void operator()(const pg8::f32x4 (&acc)[2][2][4][2], const pg8::Unit& u, int wr, int wc, int fr, int fq) const {
        const int row0 = u.pm * 256 + wr * 64 + fr, col0 = u.pn * 256 + wc * 32 + 4 * fq;
#pragma unroll
        for (int ai = 0; ai < 2; ++ai)
#pragma unroll
            for (int m = 0; m < 4; ++m) {
                const int row = row0 + ai * 128 + m * 16;
                const float sc = sumsq ? 1.0f / sqrtf(sumsq[row] * (1.0f / (float)D) + RMS_EPS) : 1.0f;
#pragma unroll
                for (int bj = 0; bj < 2; ++bj)
#pragma unroll
                    for (int n = 0; n < 2; ++n) {
                        const int col = col0 + bj * 128 + n * 16;
                        pg8::f32x4 v = acc[ai][bj][m][n] * sc;
                        if (R) v += *(const pg8::f32x4*)(R + (size_t)row * ldr + col);
                        *(pg8::f32x4*)(C + (size_t)row * ldc + col) = v;
                    }
            }
    }
};
template <int MI, int NI, int KS> DEVFN void wave_mma(const LAS unsigned char* A, const int pa, const LAS unsigned char* B, const int pb, f32x4 (&acc)[MI][NI], const int l15, const int quad) {
#pragma unroll
    for (int ks = 0; ks < KS; ++ks) {
        bf16x8 af[MI], bfr[NI];
#pragma unroll
        for (int mi = 0; mi < MI; ++mi) af[mi] = *(const LAS bf16x8*)(A + (16 * mi + l15) * pa + 64 * ks + quad * 16);
#pragma unroll
        for (int ni = 0; ni < NI; ++ni) bfr[ni] = *(const LAS bf16x8*)(B + (16 * ni + l15) * pb + 64 * ks + quad * 16);
#pragma unroll
        for (int mi = 0; mi < MI; ++mi)
#pragma unroll
            for (int ni = 0; ni < NI; ++ni) acc[mi][ni] = __builtin_amdgcn_mfma_f32_16x16x32_bf16(af[mi], bfr[ni], acc[mi][ni], 0, 0, 0);
    }
}
template <int MI, int NI, int KS> DEVFN void wave_mma_gb(const LAS unsigned char* A, const int pa, const bf16_t* __restrict__ B, const int ldb, f32x4 (&acc)[MI][NI], const int l15, const int quad) {
#pragma unroll
    for (int ks = 0; ks < KS; ++ks) {
        bf16x8 af[MI], bfr[NI];
#pragma unroll
        for (int ni = 0; ni < NI; ++ni) bfr[ni] = *(const bf16x8*)(B + (size_t)(16 * ni + l15) * ldb + 32 * ks + quad * 8);
#pragma unroll
        for (int mi = 0; mi < MI; ++mi) af[mi] = *(const LAS bf16x8*)(A + (16 * mi + l15) * pa + 64 * ks + quad * 16);
#pragma unroll
        for (int mi = 0; mi < MI; ++mi)
#pragma unroll
            for (int ni = 0; ni < NI; ++ni) acc[mi][ni] = __builtin_amdgcn_mfma_f32_16x16x32_bf16(af[mi], bfr[ni], acc[mi][ni], 0, 0, 0);
    }
}
DEVFN void ld16bf(const bf16_t* __restrict__ src, float (&v)[16]) {
    const uint4 a = *(const uint4*)src, b = *(const uint4*)(src + 8);
    const unsigned w[8] = {a.x, a.y, a.z, a.w, b.x, b.y, b.z, b.w};
#pragma unroll
    for (int i = 0; i < 8; ++i) { v[2 * i] = __uint_as_float(w[i] << 16); v[2 * i + 1] = __uint_as_float(w[i] & 0xffff0000u); }
}
constexpr int GLA_C = 64, GLA_NCH = S / GLA_C, GLA_UNITS = NB * GLA_H * GLA_NCH;
static_assert(GLA_DK == 128 && GLA_DV == 256 && GLA_R == 16, "GLA phases are written for dk 128, dv 256, gate rank 16");
DEVFN void ph_gla_s1(const P& p, const int l, LAS unsigned char* lds) {
    const int tid = tid_fresh(), w = __builtin_amdgcn_readfirstlane(tid >> 6), lane = tid & 63, l15 = lane & 15, quad = lane >> 4;
    LAS float* gbuf = (LAS float*)lds;
    LAS unsigned char* kdT = lds + 33280;
    LAS unsigned char* vT = lds + 33280 + 18432;
    for (int u = bid_fresh(); u < GLA_UNITS; u += gridDim.x) {
        const int b = u / (GLA_H * GLA_NCH), h = (u / GLA_NCH) % GLA_H, n = u % GLA_NCH;
        const size_t t0 = (size_t)b * S + (size_t)n * GLA_C;
        const int c = tid >> 3, seg = tid & 7;
        LAS float* wgs = (LAS float*)(lds + 88576);
        LAS float* ctot = wgs + 16 * 128;
        for (int i = tid; i < GLA_R * GLA_DK; i += 512) wgs[i] = p.gla_wg2[(size_t)l * GLA_R * GLA_HK + (size_t)(i >> 7) * GLA_HK + h * GLA_DK + (i & 127)];
        __syncthreads();
        {
            float gl[16]; ld16bf(p.pjb() + (t0 + c) * PLD + C_GLR, gl);
            const float* bg = p.gla_bg + (size_t)l * GLA_HK + h * GLA_DK + seg * 16;
            float a[16];
#pragma unroll
            for (int i = 0; i < 16; ++i) a[i] = bg[i];
#pragma unroll
            for (int r = 0; r < 16; ++r)
#pragma unroll
                for (int q4 = 0; q4 < 4; ++q4) { const f32x4 wv = *(const LAS f32x4*)(wgs + r * 128 + seg * 16 + q4 * 4);
#pragma unroll
                    for (int j = 0; j < 4; ++j) a[q4 * 4 + j] += gl[r] * wv[j]; }
#pragma unroll
            for (int i = 0; i < 16; ++i) gbuf[c * 129 + seg * 16 + i] = -softplusf_(-a[i]) * (1.0f / 16.0f);
        }
        {
            const bf16_t* vp = p.pjb() + (t0 + c) * PLD + C_GV + h * GLA_DV + seg * 32;
#pragma unroll
            for (int q4 = 0; q4 < 4; ++q4) {
                const uint4 x = *(const uint4*)(vp + q4 * 8); const unsigned wv[4] = {x.x, x.y, x.z, x.w};
#pragma unroll
                for (int i = 0; i < 4; ++i) {
                    *(LAS bf16_t*)(vT + (seg * 32 + q4 * 8 + 2 * i) * 144 + c * 2) = (bf16_t)(wv[i] & 0xffffu);
                    *(LAS bf16_t*)(vT + (seg * 32 + q4 * 8 + 2 * i + 1) * 144 + c * 2) = (bf16_t)(wv[i] >> 16);
                }
            }
        }
        __syncthreads();
        {
            const int d = tid & 127, qt = tid >> 7;
            float tsum = 0.f;
#pragma unroll
            for (int cc = 0; cc < 16; ++cc) tsum += gbuf[(qt * 16 + cc) * 129 + d];
            ctot[qt * 128 + d] = tsum;
            __syncthreads();
            float run = 0.f;
            for (int q2 = 0; q2 < qt; ++q2) run += ctot[q2 * 128 + d];
#pragma unroll
            for (int cc = 0; cc < 16; ++cc) { const int ci = qt * 16 + cc; run += gbuf[ci * 129 + d]; gbuf[ci * 129 + d] = run; p.gbc()[((size_t)u * GLA_C + ci) * GLA_DK + d] = run; }
            if (qt == 3) p.gdec()[(size_t)u * GLA_DK + d] = fexp(run);
            const int e = tid >> 1, hf = tid & 1;
            bf16_t* dst = p.gvT() + ((size_t)u * GLA_DV + e) * GLA_C + hf * 32;
#pragma unroll
            for (int i = 0; i < 4; ++i) *(u32x4v*)(dst + i * 8) = *(const LAS u32x4v*)(vT + e * 144 + hf * 64 + i * 16);
        }
        __syncthreads();
        {
            float kv[16]; ld16bf(p.pjb() + (t0 + c) * PLD + C_GK + h * GLA_DK + seg * 16, kv);
#pragma unroll
            for (int i = 0; i < 16; ++i) {
                const int d = seg * 16 + i;
                const float kd = kv[i] * fexp(gbuf[63 * 129 + d] - gbuf[c * 129 + d]);
                *(LAS bf16_t*)(kdT + d * 144 + c * 2) = (bf16_t)(pk2(kd, 0.f) & 0xffffu);
            }
        }
        __syncthreads();
        {
            f32x4 acc[2][8];
#pragma unroll
            for (int mi = 0; mi < 2; ++mi)
#pragma unroll
                for (int ni = 0; ni < 8; ++ni) acc[mi][ni] = zero4();
            wave_mma<2, 8, 2>(vT + 32 * w * 144, 144, kdT, 144, acc, l15, quad);
            float* U = p.gUT() + (size_t)u * GLA_DV * GLA_DK;
#pragma unroll
            for (int mi = 0; mi < 2; ++mi)
#pragma unroll
                for (int ni = 0; ni < 8; ++ni)
#pragma unroll
                    for (int j = 0; j < 4; ++j) U[(size_t)(32 * w + 16 * mi + quad * 4 + j) * GLA_DK + 16 * ni + l15] = acc[mi][ni][j];
        }
        __syncthreads();
    }
}
DEVFN void b_gla_s2(const P& p, const int l, long gid) {
    const int d = (int)(gid % GLA_DK); const int e = (int)((gid / GLA_DK) % GLA_DV); const int bh = (int)(gid / ((long)GLA_DK * GLA_DV));
    float st = 0.f;
    for (int n = 0; n < GLA_NCH; ++n) {
        const size_t u = (size_t)bh * GLA_NCH + n; const size_t o = (u * GLA_DV + e) * GLA_DK + d;
        p.gsp()[o] = (bf16_t)(pk2(st, 0.f) & 0xffffu);
        st = p.gdec()[u * GLA_DK + d] * st + p.gUT()[o];
    }
}
DEVFN void b_gla_s2x(const P& p, const int l, long gid) {
    const int d = (int)(gid % (GLA_DK / 2)) * 2; const int e = (int)((gid / (GLA_DK / 2)) % GLA_DV); const int bh = (int)(gid / ((long)(GLA_DK / 2) * GLA_DV));
    float s0 = 0.f, s1 = 0.f;
#pragma unroll 1
    for (int n0 = 0; n0 < GLA_NCH; n0 += 8) {
        float2 uv[8], dv[8];
#pragma unroll
        for (int j = 0; j < 8; ++j) { const size_t u = (size_t)bh * GLA_NCH + n0 + j; uv[j] = *(const float2*)(p.gUT() + (u * GLA_DV + e) * GLA_DK + d); dv[j] = *(const float2*)(p.gdec() + u * GLA_DK + d); }
#pragma unroll
        for (int j = 0; j < 8; ++j) { const size_t u = (size_t)bh * GLA_NCH + n0 + j;
            *(unsigned*)(p.gsp() + (u * GLA_DV + e) * GLA_DK + d) = pk2(s0, s1);
            s0 = dv[j].x * s0 + uv[j].x; s1 = dv[j].y * s1 + uv[j].y; }
    }
}
DEVFN void ph_gla_s3(const P& p, const int l, LAS unsigned char* lds) {
    const int tid = tid_fresh(), w = __builtin_amdgcn_readfirstlane(tid >> 6), lane = tid & 63, l15 = lane & 15, quad = lane >> 4;
    LAS unsigned char* qe = lds;
    LAS unsigned char* ke = lds + 17408;
    LAS unsigned char* att = lds + 34816;
    LAS float* rowsq = (LAS float*)(lds + 44032);
    LAS unsigned char* obuf = lds + 46080;
    for (int u = bid_fresh(); u < GLA_UNITS; u += gridDim.x) {
        const int b = u / (GLA_H * GLA_NCH), h = (u / GLA_NCH) % GLA_H, n = u % GLA_NCH;
        const size_t t0 = (size_t)b * S + (size_t)n * GLA_C;
        {
            const int c = tid >> 3, seg = tid & 7;
            float qv[16], kv[16];
            ld16bf(p.pjb() + (t0 + c) * PLD + C_GQ + h * GLA_DK + seg * 16, qv); ld16bf(p.pjb() + (t0 + c) * PLD + C_GK + h * GLA_DK + seg * 16, kv);
            const float* bc = p.gbc() + ((size_t)u * GLA_C + c) * GLA_DK + seg * 16;
            unsigned wq[8], wk[8];
#pragma unroll
            for (int i = 0; i < 8; ++i) {
                const float b0 = bc[2 * i], b1 = bc[2 * i + 1];
                const float e0 = fexp(b0), e1 = fexp(b1);
                wq[i] = pk2(qv[2 * i] * 0.08838834764831845f * e0, qv[2 * i + 1] * 0.08838834764831845f * e1);
                wk[i] = pk2(kv[2 * i] * __builtin_amdgcn_rcpf(e0), kv[2 * i + 1] * __builtin_amdgcn_rcpf(e1));
            }
            *(LAS u32x4v*)(qe + c * 272 + seg * 32) = (u32x4v){wq[0], wq[1], wq[2], wq[3]}; *(LAS u32x4v*)(qe + c * 272 + seg * 32 + 16) = (u32x4v){wq[4], wq[5], wq[6], wq[7]};
            *(LAS u32x4v*)(ke + c * 272 + seg * 32) = (u32x4v){wk[0], wk[1], wk[2], wk[3]}; *(LAS u32x4v*)(ke + c * 272 + seg * 32 + 16) = (u32x4v){wk[4], wk[5], wk[6], wk[7]};
        }
        __syncthreads();
        {
            const int mi0 = w >> 1, nb = (w & 1) * 2;
            f32x4 a2[1][2]; a2[0][0] = zero4(); a2[0][1] = a2[0][0];
            wave_mma<1, 2, 4>(qe + 16 * mi0 * 272, 272, ke + 16 * nb * 272, 272, a2, l15, quad);
#pragma unroll
            for (int ni = 0; ni < 2; ++ni)
#pragma unroll
                for (int j = 0; j < 4; ++j) {
                    const int cc = 16 * mi0 + quad * 4 + j, jt = 16 * (nb + ni) + l15;
                    *(LAS bf16_t*)(att + cc * 144 + jt * 2) = (bf16_t)(pk2(jt <= cc ? a2[0][ni][j] : 0.f, 0.f) & 0xffffu);
                }
        }
        __syncthreads();
        {
            f32x4 o[4][2];
#pragma unroll
            for (int mi = 0; mi < 4; ++mi) { o[mi][0] = zero4(); o[mi][1] = o[mi][0]; }
            wave_mma_gb<4, 2, 2>(att, 144, p.gvT() + ((size_t)u * GLA_DV + 32 * w) * GLA_C, GLA_C, o, l15, quad);
            wave_mma_gb<4, 2, 4>(qe, 272, p.gsp() + ((size_t)u * GLA_DV + 32 * w) * GLA_DK, GLA_DK, o, l15, quad);
#pragma unroll
            for (int mi = 0; mi < 4; ++mi)
#pragma unroll
                for (int j = 0; j < 4; ++j) {
                    float s2 = o[mi][0][j] * o[mi][0][j] + o[mi][1][j] * o[mi][1][j];
                    s2 += __shfl_xor(s2, 1); s2 += __shfl_xor(s2, 2); s2 += __shfl_xor(s2, 4); s2 += __shfl_xor(s2, 8);
                    if (l15 == 0) rowsq[w * 64 + 16 * mi + quad * 4 + j] = s2;
                }
            __syncthreads();
            const float* ng = p.gla_norm_g + (size_t)l * GW + h * GLA_DV + 32 * w;
#pragma unroll
            for (int mi = 0; mi < 4; ++mi)
#pragma unroll
                for (int j = 0; j < 4; ++j) {
                    const int cc = 16 * mi + quad * 4 + j;
                    float rq = 0.f;
#pragma unroll
                    for (int ww = 0; ww < 8; ++ww) rq += rowsq[ww * 64 + cc];
                    const float rs = 1.0f / sqrtf(rq * (1.0f / (float)GLA_DV) + RMS_EPS);
#pragma unroll
                    for (int ni = 0; ni < 2; ++ni) {
                        const int e = 16 * ni + l15;
                        *(LAS bf16_t*)(obuf + cc * 528 + (32 * w + e) * 2) = (bf16_t)(pk2(o[mi][ni][j] * rs * ng[e], 0.f) & 0xffffu);
                    }
                }
            __syncthreads();
            {
                const int c2 = tid >> 3, es = (tid & 7) * 32;
                const bf16_t* ogp = p.pjb() + (t0 + c2) * PLD + C_GOG + h * GLA_DV + es; bf16_t* dst = p.mixedb() + (t0 + c2) * D + GW + h * GLA_DV + es;
#pragma unroll
                for (int i = 0; i < 4; ++i) {
                    const uint4 gw = *(const uint4*)(ogp + i * 8); const u32x4v ow = *(const LAS u32x4v*)(obuf + c2 * 528 + (es + i * 8) * 2);
                    const unsigned g4[4] = {gw.x, gw.y, gw.z, gw.w}; const unsigned o4[4] = {ow.x, ow.y, ow.z, ow.w}; unsigned r4[4];
#pragma unroll
                    for (int jj = 0; jj < 4; ++jj) { const float g0 = __uint_as_float(g4[jj] << 16), g1 = __uint_as_float(g4[jj] & 0xffff0000u);
                        r4[jj] = pk2(__uint_as_float(o4[jj] << 16) * (g0 * sigmoidf_(g0)), __uint_as_float(o4[jj] & 0xffff0000u) * (g1 * sigmoidf_(g1))); }
                    *(uint4*)(dst + i * 8) = make_uint4(r4[0], r4[1], r4[2], r4[3]);
                }
            }
        }
        __syncthreads();
    }
}

DEVFN void b_lru_conv2(const P& p, const int l, long gid) {
    const long t = gid / (GW / 8); const int c = (int)(gid % (GW / 8)) * 8; const int s = (int)(t % S);
    const float* cw = p.lru_conv_w + (size_t)l * 4 * GW + c; const float* cb = p.lru_conv_b + (size_t)l * GW + c;
    float acc[8];
#pragma unroll
    for (int i = 0; i < 8; ++i) acc[i] = cb[i];
#pragma unroll
    for (int j = 0; j < 4; ++j) {
        if (s - 3 + j >= 0) {
            const uint4 x = *(const uint4*)(p.pjb() + (size_t)(t - 3 + j) * PLD + C_LRUX + c); const unsigned w[4] = {x.x, x.y, x.z, x.w};
#pragma unroll
            for (int i = 0; i < 4; ++i) { acc[2 * i] += cw[j * GW + 2 * i] * __uint_as_float(w[i] << 16); acc[2 * i + 1] += cw[j * GW + 2 * i + 1] * __uint_as_float(w[i] & 0xffff0000u); }
        }
    }
    *(uint4*)(p.lxcb() + (size_t)t * GW + c) = make_uint4(pk2(acc[0], acc[1]), pk2(acc[2], acc[3]), pk2(acc[4], acc[5]), pk2(acc[6], acc[7]));
}
DEVFN void b_lru_conv3(const P& p, const int l, long gid) {
    const long tg = gid / (GW / 8); const int c = (int)(gid % (GW / 8)) * 8; const long t = tg * 4; const int s = (int)(t % S);
    const float* cw = p.lru_conv_w + (size_t)l * 4 * GW + c; const float* cb = p.lru_conv_b + (size_t)l * GW + c;
    float w[4][8], x[7][8], bias[8];
#pragma unroll
    for (int j = 0; j < 4; ++j) { const float4 a = *(const float4*)(cw + j * GW), b = *(const float4*)(cw + j * GW + 4); w[j][0] = a.x; w[j][1] = a.y; w[j][2] = a.z; w[j][3] = a.w; w[j][4] = b.x; w[j][5] = b.y; w[j][6] = b.z; w[j][7] = b.w; }
    { const float4 a = *(const float4*)cb, b = *(const float4*)(cb + 4); bias[0] = a.x; bias[1] = a.y; bias[2] = a.z; bias[3] = a.w; bias[4] = b.x; bias[5] = b.y; bias[6] = b.z; bias[7] = b.w; }
#pragma unroll
    for (int r = 0; r < 7; ++r) {
        uint4 v = make_uint4(0u, 0u, 0u, 0u);
        if (s + r - 3 >= 0) v = *(const uint4*)(p.pjb() + (size_t)(t + r - 3) * PLD + C_LRUX + c);
        const unsigned vw[4] = {v.x, v.y, v.z, v.w};
#pragma unroll
        for (int i = 0; i < 4; ++i) { x[r][2 * i] = __uint_as_float(vw[i] << 16); x[r][2 * i + 1] = __uint_as_float(vw[i] & 0xffff0000u); }
    }
#pragma unroll
    for (int k = 0; k < 4; ++k) {
        float acc[8];
#pragma unroll
        for (int i = 0; i < 8; ++i) { acc[i] = bias[i];
#pragma unroll
            for (int j = 0; j < 4; ++j) acc[i] += w[j][i] * x[k + j][i]; }
        *(uint4*)(p.lxcb() + ((size_t)(c / LRU_BLK) * T + (size_t)(t + k)) * LRU_BLK + (c % LRU_BLK)) = make_uint4(pk2(acc[0], acc[1]), pk2(acc[2], acc[3]), pk2(acc[4], acc[5]), pk2(acc[6], acc[7]));
    }
}
DEVFN void b_lru_wprep(const P& p, const int l, long gid) {
    const int n = (int)(gid / (GW / 8)), k0 = (int)(gid % (GW / 8)) * 8; const int nn = n % GW, blk = nn / LRU_BLK, j = nn % LRU_BLK;
    unsigned w[4] = {0u, 0u, 0u, 0u};
    if (k0 / LRU_BLK == blk) {
        const float* src = (n < GW ? p.lru_wa : p.lru_wx) + ((size_t)l * LRU_NBLK + blk) * LRU_BLK * LRU_BLK + (size_t)(k0 % LRU_BLK) * LRU_BLK + j;
#pragma unroll
        for (int i = 0; i < 4; ++i) w[i] = pk2(src[(2 * i) * LRU_BLK], src[(2 * i + 1) * LRU_BLK]);
    }
    *(uint4*)(p.lruW() + (size_t)n * GW + k0) = make_uint4(w[0], w[1], w[2], w[3]);
}
struct EpiLru {
    static constexpr bool PERM = false, AFTER_DRAIN = false;
    float* LA; float* LB; const bf16_t* xcb; const float* ba; const float* bx; const float* lam;
    __device__ __forceinline__ void operator()(const pg8::f32x4 (&acc)[2][2][4][2], const pg8::Unit& u, int wr, int wc, int fr, int fq) const {
        const int row0 = u.pm * 256 + wr * 64 + fr, col0 = u.pn * 256 + wc * 32 + 4 * fq;
        const bool rg = col0 < GW;
#pragma unroll
        for (int bj = 0; bj < 2; ++bj)
#pragma unroll
            for (int n = 0; n < 2; ++n) {
                const int col = col0 + bj * 128 + n * 16, c = rg ? col : col - GW;
                const pg8::f32x4 bias = *(const pg8::f32x4*)((rg ? ba : bx) + c);
                pg8::f32x4 sp = zero4();
                if (rg) { const pg8::f32x4 lm = *(const pg8::f32x4*)(lam + c);
#pragma unroll
                    for (int j = 0; j < 4; ++j) sp[j] = softplusf_(-lm[j]); }
#pragma unroll
                for (int ai = 0; ai < 2; ++ai)
#pragma unroll
                    for (int m = 0; m < 4; ++m) {
                        const int row = row0 + ai * 128 + m * 16;
                        const pg8::f32x4 v = acc[ai][bj][m][n] + bias;
                        pg8::f32x4 o;
                        if (rg) {
#pragma unroll
                            for (int j = 0; j < 4; ++j) o[j] = -8.0f * sigmoidf_(v[j]) * sp[j];
                            *(pg8::f32x4*)(LA + (size_t)row * GW + c) = o;
                        } else {
                            const uint2 xw = *(const uint2*)(xcb + (size_t)row * GW + c);
                            o[0] = sigmoidf_(v[0]) * __uint_as_float(xw.x << 16); o[1] = sigmoidf_(v[1]) * __uint_as_float(xw.x & 0xffff0000u);
                            o[2] = sigmoidf_(v[2]) * __uint_as_float(xw.y << 16); o[3] = sigmoidf_(v[3]) * __uint_as_float(xw.y & 0xffff0000u);
                            *(pg8::f32x4*)(LB + (size_t)row * GW + c) = o;
                        }
                    }
            }
    }
};
DEVFN void b_lru_wprep2(const P& p, const int l, long gid) {
    const int k0 = (int)(gid & 15) * 8, row = (int)((gid >> 4) & 255), n = (int)(gid >> 12), j = row & 127;
    const float* src = (row < 128 ? p.lru_wa : p.lru_wx) + ((size_t)l * LRU_NBLK + n) * LRU_BLK * LRU_BLK + (size_t)k0 * LRU_BLK + j;
    unsigned w[4];
#pragma unroll
    for (int i = 0; i < 4; ++i) w[i] = pk2(src[(2 * i) * LRU_BLK], src[(2 * i + 1) * LRU_BLK]);
    *(uint4*)(p.lruW() + ((size_t)n * 256 + row) * LRU_BLK + k0) = make_uint4(w[0], w[1], w[2], w[3]);
}
struct DiagOrder {
    int c, G;
    __device__ __forceinline__ bool next(int i, pg8::Unit& u) const { const int idx = i * G + c; if (idx >= LRU_NBLK * (T / 256)) return false; u.pm = idx; u.pn = idx / (T / 256); return true; }
    __device__ __forceinline__ void a_ready(const pg8::Unit&) const {}
    __device__ __forceinline__ void done(const pg8::Unit&) const {}
};
struct EpiLru2 {
    static constexpr bool PERM = false, AFTER_DRAIN = false;
    float* LA; float* LB; const bf16_t* xcb; const float* ba; const float* bx; const float* lam;
    __device__ __forceinline__ void operator()(const pg8::f32x4 (&acc)[2][2][4][2], const pg8::Unit& u, int wr, int wc, int fr, int fq) const {
        const int n = u.pn, row0 = (u.pm - n * (T / 256)) * 256 + wr * 64 + fr, cb = wc * 32 + 4 * fq;
#pragma unroll
        for (int nn = 0; nn < 2; ++nn) {
            const int c = n * LRU_BLK + cb + nn * 16;
            const pg8::f32x4 br = *(const pg8::f32x4*)(ba + c), bi = *(const pg8::f32x4*)(bx + c), lm = *(const pg8::f32x4*)(lam + c);
            pg8::f32x4 sp;
#pragma unroll
            for (int j = 0; j < 4; ++j) sp[j] = -8.0f * softplusf_(-lm[j]);
#pragma unroll
            for (int ai = 0; ai < 2; ++ai)
#pragma unroll
                for (int m = 0; m < 4; ++m) {
                    const int row = row0 + ai * 128 + m * 16;
                    const uint2 xw = *(const uint2*)(xcb + ((size_t)n * T + row) * LRU_BLK + cb + nn * 16);
                    const float xc[4] = {__uint_as_float(xw.x << 16), __uint_as_float(xw.x & 0xffff0000u), __uint_as_float(xw.y << 16), __uint_as_float(xw.y & 0xffff0000u)};
                    const pg8::f32x4 vr = acc[ai][0][m][nn] + br, vi = acc[ai][1][m][nn] + bi;
                    pg8::f32x4 oa, ob;
#pragma unroll
                    for (int j = 0; j < 4; ++j) { const float a = fexp(sigmoidf_(vr[j]) * sp[j]); oa[j] = a; ob[j] = __builtin_amdgcn_sqrtf(fmaxf(1.0f - a * a, 0.0f)) * sigmoidf_(vi[j]) * xc[j]; }
                    *(pg8::f32x4*)(LA + (size_t)row * GW + c) = oa; *(pg8::f32x4*)(LB + (size_t)row * GW + c) = ob;
                }
        }
    }
};
DEVFN void ph_lru_scan(const P& p, const int l, LAS unsigned char* lds) {
    static_assert(S == 4096, "scan geometry: 64 segments of 64 steps");
    const int tid = tid_fresh(), ch = tid & 7, seg = tid >> 3;
    LAS float* sP = (LAS float*)lds; LAS float* sH = sP + 512;
    for (int u = bid_fresh(); u < NB * (GW / 8); u += gridDim.x) {
        const int b = u / (GW / 8), c = (u % (GW / 8)) * 8 + ch;
        const size_t t0 = (size_t)b * S + (size_t)seg * 64;
        float av[64], bv[64];
        { const float* pa = p.lA() + t0 * GW + c; const float* pb = p.lB() + t0 * GW + c;
#pragma unroll
          for (int i = 0; i < 64; ++i) { av[i] = *pa; bv[i] = *pb; pa += GW; pb += GW; asm volatile("" : "+v"(pa), "+v"(pb)); } }
        float Pp = 1.f, H = 0.f;
#pragma unroll
        for (int i = 0; i < 64; ++i) { const float a = av[i]; H = a * H + bv[i]; Pp *= a; }
        sP[seg * 8 + ch] = Pp; sH[seg * 8 + ch] = H;
        __syncthreads();
        float h = 0.f;
        for (int s2 = 0; s2 < seg; ++s2) h = sP[s2 * 8 + ch] * h + sH[s2 * 8 + ch];
        LAS unsigned char* hb = lds + 4096;
#pragma unroll
        for (int i = 0; i < 64; ++i) { h = av[i] * h + bv[i]; *(LAS bf16_t*)(hb + seg * 1040 + i * 16 + ch * 2) = (bf16_t)(pk2(h, 0.f) & 0xffffu); }
        __syncthreads();
        {
            const int cb = (u % (GW / 8)) * 8;
#pragma unroll
            for (int i = 0; i < S / 512; ++i) {
                const int tk = tid + 512 * i; const size_t t = (size_t)b * S + tk;
                const uint4 gw = *(const uint4*)(p.pjb() + t * PLD + C_LRUG + cb); const u32x4v hw = *(const LAS u32x4v*)(hb + (tk >> 6) * 1040 + (tk & 63) * 16);
                const unsigned g4[4] = {gw.x, gw.y, gw.z, gw.w}; const unsigned h4[4] = {hw.x, hw.y, hw.z, hw.w}; unsigned o4[4];
#pragma unroll
                for (int j = 0; j < 4; ++j) o4[j] = pk2(__uint_as_float(h4[j] << 16) * gelu_tanhf_(__uint_as_float(g4[j] << 16)), __uint_as_float(h4[j] & 0xffff0000u) * gelu_tanhf_(__uint_as_float(g4[j] & 0xffff0000u)));
                *(uint4*)(p.mixedb() + t * D + cb) = make_uint4(o4[0], o4[1], o4[2], o4[3]);
            }
        }
        __syncthreads();
    }
}

static_assert(S5_P == 64 && S5_HG == 16 && S5_G == 64 && S == 4096, "S5 phases are written for 64 groups x 16 channels, 64 complex states, 64 chunks of 64 tokens");
constexpr int S5_L = 64, S5_NCH = S / S5_L, S5_K = S5_L * S5_HG  , S5_P2 = 2 * S5_P  ;
DEVFN void b_s5_pre2(const P& p, const int l, long gid) {
    const int g = (int)(gid / S5_P);
    const float step = expf(p.s5_log_step[(size_t)l * S5_G + g]);
    const float lr = p.s5_a_re[(size_t)l * S5_GP + gid], li = p.s5_a_im[(size_t)l * S5_GP + gid];
    const float mag = expf(lr * step), ang = li * step;
    const float are = mag * cosf(ang), aim = mag * sinf(ang);
    const float den = lr * lr + li * li;
    const float fre = ((are - 1.0f) * lr + aim * li) / den, fim = (aim * lr - (are - 1.0f) * li) / den;
    for (int h = 0; h < S5_HG; ++h) {
        const float br = p.s5_b_re[((size_t)l * S5_GP + gid) * S5_HG + h], bi = p.s5_b_im[((size_t)l * S5_GP + gid) * S5_HG + h];
        p.s5bb()[(gid * S5_HG + h) * 2] = fre * br - fim * bi; p.s5bb()[(gid * S5_HG + h) * 2 + 1] = fre * bi + fim * br;
    }
}
DEVFN void b_s5_pw(const P& p, const int l, long gid) {
    const long gp = gid / (S5_L + 1); const int k = (int)(gid % (S5_L + 1)), g = (int)(gp / S5_P);
    const float step = expf(p.s5_log_step[(size_t)l * S5_G + g]);
    const float lr = p.s5_a_re[(size_t)l * S5_GP + gp], li = p.s5_a_im[(size_t)l * S5_GP + gp];
    const float mk = expf((float)k * (lr * step)), ak = (float)k * (li * step);
    p.s5pw()[gid * 2] = mk * cosf(ak); p.s5pw()[gid * 2 + 1] = mk * sinf(ak);
}
DEVFN void b_s5_ktoep(const P& p, const int l, long gid) {
    const int hp = (int)(gid & 15), h = (int)((gid >> 4) & 15), tau = (int)((gid >> 8) & 63), g = (int)(gid >> 14);
    const float* cr = p.s5_c_re + (((size_t)l * S5_G + g) * S5_HG + h) * S5_P; const float* ci = p.s5_c_im + (((size_t)l * S5_G + g) * S5_HG + h) * S5_P;
    float acc = 0.f;
    for (int q = 0; q < S5_P; ++q) {
        const size_t gp = (size_t)g * S5_P + q;
        const float wr = p.s5pw()[(gp * (S5_L + 1) + tau) * 2], wi = p.s5pw()[(gp * (S5_L + 1) + tau) * 2 + 1];
        const float br = p.s5bb()[(gp * S5_HG + hp) * 2], bi = p.s5bb()[(gp * S5_HG + hp) * 2 + 1];
        const float xr = cr[q] * wr - ci[q] * wi, xi = cr[q] * wi + ci[q] * wr;
        acc += xr * br - xi * bi;
    }
    p.s5kt()[gid] = (bf16_t)(pk2(acc, 0.f) & 0xffffu);
}
DEVFN void ph_s5_ktoep(const P& p, const int l, LAS unsigned char* lds, const int first, const int cnt) {
    const int tid = tid_fresh(); const int vb = bid_fresh() - first;
    if (vb < 0 || vb >= cnt) return;
    typedef float f32x2_ __attribute__((ext_vector_type(2)));
    LAS f32x2_* pwl = (LAS f32x2_*)lds;
    LAS float* part = (LAS float*)(lds + 32768);
    const int pair = tid & 255, h = pair >> 4, hp = pair & 15, ph = tid >> 8, q0 = ph * 32;
    for (int g = vb; g < S5_G; g += cnt) {
        for (int i = tid; i < S5_P * S5_L; i += 512) { const int q = i >> 6, tau = i & 63; const float* src = p.s5pw() + (((size_t)g * S5_P + q) * (S5_L + 1) + tau) * 2; pwl[tau * 64 + q] = (f32x2_){src[0], src[1]}; }
        float zr[32], zi[32];
        const float* cr = p.s5_c_re + (((size_t)l * S5_G + g) * S5_HG + h) * S5_P + q0; const float* ci = p.s5_c_im + (((size_t)l * S5_G + g) * S5_HG + h) * S5_P + q0;
#pragma unroll
        for (int q = 0; q < 32; ++q) {
            const float br = p.s5bb()[(((size_t)g * S5_P + q0 + q) * S5_HG + hp) * 2], bi = p.s5bb()[(((size_t)g * S5_P + q0 + q) * S5_HG + hp) * 2 + 1];
            zr[q] = cr[q] * br - ci[q] * bi; zi[q] = cr[q] * bi + ci[q] * br;
        }
        __syncthreads();
        if (ph == 1) {
#pragma unroll 1
            for (int tau = 0; tau < S5_L; ++tau) {
                float acc = 0.f;
#pragma unroll
                for (int q = 0; q < 32; ++q) { const f32x2_ w = pwl[tau * 64 + 32 + q]; acc += zr[q] * w.x - zi[q] * w.y; }
                part[tau * 256 + pair] = acc;
            }
        }
        __syncthreads();
        if (ph == 0) {
#pragma unroll 1
            for (int tau = 0; tau < S5_L; ++tau) {
                float acc = part[tau * 256 + pair];
#pragma unroll
                for (int q = 0; q < 32; ++q) { const f32x2_ w = pwl[tau * 64 + q]; acc += zr[q] * w.x - zi[q] * w.y; }
                p.s5kt()[(((size_t)g * S5_L + tau) * S5_HG + h) * S5_HG + hp] = (bf16_t)(pk2(acc, 0.f) & 0xffffu);
            }
        }
        __syncthreads();
    }
}
DEVFN void b_s5_wend(const P& p, const int l, long gid) {
    const int k0 = (int)(gid & 127) * 8, p2 = (int)((gid >> 7) & 127), g = (int)(gid >> 14);
    const int q = p2 & 63, im = p2 >> 6, s = k0 >> 4, h0 = k0 & 15;
    const size_t gp = (size_t)g * S5_P + q;
    const float wr = p.s5pw()[(gp * (S5_L + 1) + (63 - s)) * 2], wi = p.s5pw()[(gp * (S5_L + 1) + (63 - s)) * 2 + 1];
    float v[8];
#pragma unroll
    for (int i = 0; i < 8; ++i) { const float br = p.s5bb()[(gp * S5_HG + h0 + i) * 2], bi = p.s5bb()[(gp * S5_HG + h0 + i) * 2 + 1]; v[i] = im ? (wr * bi + wi * br) : (wr * br - wi * bi); }
    *(uint4*)(p.s5we() + ((size_t)g * S5_P2 + p2) * S5_K + k0) = make_uint4(pk2(v[0], v[1]), pk2(v[2], v[3]), pk2(v[4], v[5]), pk2(v[6], v[7]));
}
DEVFN void b_s5_mc(const P& p, const int l, long gid) {
    const int p0 = (int)(gid & 15) * 8, n = (int)((gid >> 4) & 1023), g = (int)(gid >> 14);
    const int t = n >> 4, h = n & 15, im = p0 >> 6, q0 = p0 & 63;
    const float* cr = p.s5_c_re + (((size_t)l * S5_G + g) * S5_HG + h) * S5_P + q0; const float* ci = p.s5_c_im + (((size_t)l * S5_G + g) * S5_HG + h) * S5_P + q0;
    float v[8];
#pragma unroll
    for (int i = 0; i < 8; ++i) {
        const size_t gp = (size_t)g * S5_P + q0 + i;
        const float wr = p.s5pw()[(gp * (S5_L + 1) + t + 1) * 2], wi = p.s5pw()[(gp * (S5_L + 1) + t + 1) * 2 + 1];
        v[i] = im ? -(cr[i] * wi + ci[i] * wr) : (cr[i] * wr - ci[i] * wi);
    }
    *(uint4*)(p.s5mc() + ((size_t)g * S5_K + n) * S5_P2 + p0) = make_uint4(pk2(v[0], v[1]), pk2(v[2], v[3]), pk2(v[4], v[5]), pk2(v[6], v[7]));
}
DEVFN void ph_s5_e(const P& p, const int l) {
    const int tid = tid_fresh(), w = __builtin_amdgcn_readfirstlane(tid >> 6), lane = tid & 63, l15 = lane & 15, quad = lane >> 4;
    for (int u = bid_fresh(); u < NB * S5_G; u += gridDim.x) {
        const int b = u / S5_G, g = u % S5_G, mi = w >> 1, nh = w & 1;
        const bf16_t* ap = p.pjb() + ((size_t)b * S + (size_t)(16 * mi + l15) * S5_L + (quad >> 1)) * PLD + C_S5U + g * S5_HG + (quad & 1) * 8;
        const bf16_t* bp = p.s5we() + ((size_t)g * S5_P2 + 64 * nh + l15) * S5_K + quad * 8;
        f32x4 acc[4];
#pragma unroll
        for (int ni = 0; ni < 4; ++ni) acc[ni] = zero4();
#pragma unroll 4
        for (int ks = 0; ks < 32; ++ks) {
            const bf16x8 af = *(const bf16x8*)(ap + (size_t)(2 * ks) * PLD);
#pragma unroll
            for (int ni = 0; ni < 4; ++ni) { const bf16x8 bfr = *(const bf16x8*)(bp + (size_t)(16 * ni) * S5_K + 32 * ks); acc[ni] = __builtin_amdgcn_mfma_f32_16x16x32_bf16(af, bfr, acc[ni], 0, 0, 0); }
        }
        float* eo = p.s5el() + ((size_t)u * S5_NCH) * S5_P2;
#pragma unroll
        for (int ni = 0; ni < 4; ++ni)
#pragma unroll
            for (int j = 0; j < 4; ++j) eo[(size_t)(16 * mi + quad * 4 + j) * S5_P2 + 64 * nh + 16 * ni + l15] = acc[ni][j];
    }
}
constexpr int S5Y_UP = 2064;
DEVFN void ph_s5_y(const P& p, const int l, LAS unsigned char* lds) {
    const int tid = tid_fresh(), w = __builtin_amdgcn_readfirstlane(tid >> 6), lane = tid & 63, l15 = lane & 15, quad = lane >> 4;
    LAS unsigned char* Ut = lds;
    LAS unsigned char* Kt = lds + 32 * S5Y_UP;
    LAS unsigned char* Ei = Kt + 32768;
    for (int u = bid_fresh(); u < NB * S5_G * 2; u += gridDim.x) {
        const int half = u & 1, g = (u >> 1) % S5_G, b = u / (2 * S5_G);
#pragma unroll
        for (int i = 0; i < 8; ++i) {
            const int q = tid + 512 * i, r = q >> 7, s = (q >> 1) & 63, hh = q & 1;
            *(LAS u32x4v*)(Ut + r * S5Y_UP + (s * 16 + hh * 8) * 2) = *(const u32x4v*)(p.pjb() + ((size_t)b * S + (size_t)(32 * half + r) * S5_L + s) * PLD + C_S5U + g * S5_HG + hh * 8);
        }
#pragma unroll
        for (int i = 0; i < 4; ++i) *(LAS u32x4v*)(Kt + (tid + 512 * i) * 16) = *(const u32x4v*)(p.s5kt() + (size_t)g * 16384 + (size_t)(tid + 512 * i) * 8);
        if (tid < S5_P) {
            const size_t gp = (size_t)g * S5_P + tid;
            const float ar = p.s5pw()[(gp * (S5_L + 1) + S5_L) * 2], ai = p.s5pw()[(gp * (S5_L + 1) + S5_L) * 2 + 1];
            const float* el = p.s5el() + ((size_t)(b * S5_G + g) * S5_NCH) * S5_P2;
            float er = 0.f, ei = 0.f;
#pragma unroll 1
            for (int n0 = 0; n0 < 32 * half + 32; n0 += 8) {
                float lr_[8], li_[8];
#pragma unroll
                for (int j = 0; j < 8; ++j) { lr_[j] = el[(size_t)(n0 + j) * S5_P2 + tid]; li_[j] = el[(size_t)(n0 + j) * S5_P2 + 64 + tid]; }
#pragma unroll
                for (int j = 0; j < 8; ++j) {
                    const int n = n0 + j;
                    if (n >= 32 * half) { *(LAS bf16_t*)(Ei + (n - 32 * half) * 272 + tid * 2) = (bf16_t)(pk2(er, 0.f) & 0xffffu); *(LAS bf16_t*)(Ei + (n - 32 * half) * 272 + (64 + tid) * 2) = (bf16_t)(pk2(ei, 0.f) & 0xffffu); }
                    const float nr = ar * er - ai * ei + lr_[j], ni = ar * ei + ai * er + li_[j];
                    er = nr; ei = ni;
                }
            }
        }
        __syncthreads();
        const float dcoef = p.s5_d[(size_t)l * GW + g * S5_HG + l15];
#pragma unroll 1
        for (int tt = 0; tt < 8; ++tt) {
            const int t = w + 8 * tt;
            f32x4 acc[2]; acc[0] = zero4(); acc[1] = acc[0];
            const int nks = (t >> 1) + 1;
#pragma unroll 2
            for (int ks = 0; ks < nks; ++ks) {
                const int tau = t - (2 * ks + (quad >> 1));
                u32x4v kw = zero4u();
                if (tau >= 0) kw = *(const LAS u32x4v*)(Kt + ((tau * 16 + l15) * 16 + (quad & 1) * 8) * 2);
                const bf16x8 bfr = __builtin_bit_cast(bf16x8, kw);
                const bf16x8 a0 = *(const LAS bf16x8*)(Ut + l15 * S5Y_UP + 64 * ks + quad * 16), a1 = *(const LAS bf16x8*)(Ut + (16 + l15) * S5Y_UP + 64 * ks + quad * 16);
                acc[0] = __builtin_amdgcn_mfma_f32_16x16x32_bf16(a0, bfr, acc[0], 0, 0, 0); acc[1] = __builtin_amdgcn_mfma_f32_16x16x32_bf16(a1, bfr, acc[1], 0, 0, 0);
            }
            const bf16_t* mp = p.s5mc() + ((size_t)g * S5_K + t * 16 + l15) * S5_P2 + quad * 8;
#pragma unroll
            for (int ks = 0; ks < 4; ++ks) {
                const bf16x8 bfr = *(const bf16x8*)(mp + 32 * ks);
                const bf16x8 a0 = *(const LAS bf16x8*)(Ei + l15 * 272 + 64 * ks + quad * 16), a1 = *(const LAS bf16x8*)(Ei + (16 + l15) * 272 + 64 * ks + quad * 16);
                acc[0] = __builtin_amdgcn_mfma_f32_16x16x32_bf16(a0, bfr, acc[0], 0, 0, 0); acc[1] = __builtin_amdgcn_mfma_f32_16x16x32_bf16(a1, bfr, acc[1], 0, 0, 0);
            }
#pragma unroll
            for (int mi = 0; mi < 2; ++mi)
#pragma unroll
                for (int j = 0; j < 4; ++j) {
                    const int r = 16 * mi + quad * 4 + j;
                    const float uu = bf2f(*(const LAS bf16_t*)(Ut + r * S5Y_UP + (t * 16 + l15) * 2));
                    const float y = acc[mi][j] + dcoef * uu;
                    p.s5zb()[((size_t)b * S + (size_t)(32 * half + r) * S5_L + t) * GW + g * S5_HG + l15] = (bf16_t)(pk2(gelu_tanhf_(y), 0.f) & 0xffffu);
                }
        }
        __syncthreads();
    }
}
struct EpiGlu {
    static constexpr bool PERM = true, AFTER_DRAIN = false;
    bf16_t* O; const bf16_t* Z; const float* bias; int ldo; int ldz;
    __device__ __forceinline__ void operator()(const pg8::f32x4 (&acc)[2][2][4][2], const pg8::Unit& u, int wr, int wc, int fr, int fq) const {
        const int row0 = u.pm * 256 + wr * 64 + fr, col0 = u.pn * 256 + wc * 32 + 8 * fq;
#pragma unroll
        for (int bj = 0; bj < 2; ++bj) {
            const int col = col0 + bj * 128;
            const pg8::f32x4 b0 = *(const pg8::f32x4*)(bias + col), b1 = *(const pg8::f32x4*)(bias + col + 4);
#pragma unroll
            for (int ai = 0; ai < 2; ++ai)
#pragma unroll
                for (int m = 0; m < 4; ++m) {
                    const int row = row0 + ai * 128 + m * 16;
                    const pg8::u32x4 zw = *(const pg8::u32x4*)(Z + (size_t)row * ldz + col);
                    const pg8::f32x4 v0 = acc[ai][bj][m][0] + b0, v1 = acc[ai][bj][m][1] + b1;
                    pg8::u32x4 o;
                    o.x = pk2(__uint_as_float(zw.x << 16) * sigmoidf_(v0[0]), __uint_as_float(zw.x & 0xffff0000u) * sigmoidf_(v0[1]));
                    o.y = pk2(__uint_as_float(zw.y << 16) * sigmoidf_(v0[2]), __uint_as_float(zw.y & 0xffff0000u) * sigmoidf_(v0[3]));
                    o.z = pk2(__uint_as_float(zw.z << 16) * sigmoidf_(v1[0]), __uint_as_float(zw.z & 0xffff0000u) * sigmoidf_(v1[1]));
                    o.w = pk2(__uint_as_float(zw.w << 16) * sigmoidf_(v1[2]), __uint_as_float(zw.w & 0xffff0000u) * sigmoidf_(v1[3]));
                    *(pg8::u32x4*)(O + (size_t)row * ldo + col) = o;
                }
        }
    }
};

DEVFN unsigned f2ord(float f) { const unsigned u = __float_as_uint(f); return u ^ ((u >> 31) ? 0xFFFFFFFFu : 0x80000000u); }
constexpr int PER_TT = 32, PER_SP = 129;
DEVFN void ph_pe_route(const P& p, const int l, LAS unsigned char* lds, const bool dry = false) {
    static_assert(PE_NK == 128 && PE_K == 16 && PE_DH == 128, "routing phase is written for 128 sub-keys of width 128, top-16");
    const int tid = tid_fresh(), w = __builtin_amdgcn_readfirstlane(tid >> 6), lane = tid & 63, l15 = lane & 15, quad = lane >> 4, half = lane >> 5, li = lane & 31;
    LAS float* Ssm = (LAS float*)lds;
    int ca = 0, cstart = 0;
    {
        const int th[15] = {16, 24, 29, 33, 36, 38, 40, 42, 43, 44, 45, 46, 47, 48, 49};
#pragma unroll
        for (int i = 0; i < 15; ++i) if (lane >= th[i]) { ca = i + 1; cstart = th[i]; }
    }
    const int cb = lane - cstart; const bool cvalid = lane < 50; const unsigned cflat = (unsigned)(ca * 16 + (cb & 15));
    for (int u = bid_fresh(); u < T / PER_TT; u += gridDim.x) {
        const int tok0 = u * PER_TT;
#pragma unroll 1
        for (int h = 0; h < PE_H; ++h) {
            {
                const int c = w >> 2, ntp = w & 3;
                const bf16_t* qb = p.pqb() + (size_t)(tok0 + l15) * PE_QW + (h * 2 + c) * PE_DH + quad * 8;
                const bf16_t* sb = p.skb() + (((size_t)(h * 2 + c)) * PE_NK + 32 * ntp + l15) * PE_DH + quad * 8;
                bf16x8 bfr[2][4];
#pragma unroll
                for (int n2 = 0; n2 < 2; ++n2)
#pragma unroll
                    for (int ks = 0; ks < 4; ++ks) bfr[n2][ks] = *(const bf16x8*)(sb + (size_t)n2 * 16 * PE_DH + 32 * ks);
#pragma unroll
                for (int mt = 0; mt < 2; ++mt) {
                    bf16x8 afr[4];
#pragma unroll
                    for (int ks = 0; ks < 4; ++ks) afr[ks] = *(const bf16x8*)(qb + (size_t)mt * 16 * PE_QW + 32 * ks);
                    f32x4 a0 = zero4(), a1 = a0;
#pragma unroll
                    for (int ks = 0; ks < 4; ++ks) { a0 = __builtin_amdgcn_mfma_f32_16x16x32_bf16(afr[ks], bfr[0][ks], a0, 0, 0, 0); a1 = __builtin_amdgcn_mfma_f32_16x16x32_bf16(afr[ks], bfr[1][ks], a1, 0, 0, 0); }
#pragma unroll
                    for (int e = 0; e < 4; ++e) { LAS float* r = Ssm + (c * PER_TT + 16 * mt + quad * 4 + e) * PER_SP + 32 * ntp + l15; r[0] = a0[e]; r[16] = a1[e]; }
                }
            }
            __syncthreads();
#pragma unroll 1
            for (int tt = 0; tt < PER_TT / 8; tt += 2) {
                int tl[2]; size_t t[2]; float rstd[2]; const LAS float* row[2]; unsigned pk[2][4]; int myidx[2] = {0, 0};
#pragma unroll
                for (int z = 0; z < 2; ++z) {
                    tl[z] = (PER_TT / 8) * w + tt + z; t[z] = (size_t)tok0 + tl[z];
                    float rsum = dpp_rowsum_f(p.ssp()[t[z] * 64 + lane]);
                    { const int ri = __float_as_int(rsum);
                      rsum = (__int_as_float(__builtin_amdgcn_readlane(ri, 0)) + __int_as_float(__builtin_amdgcn_readlane(ri, 16))) + (__int_as_float(__builtin_amdgcn_readlane(ri, 32)) + __int_as_float(__builtin_amdgcn_readlane(ri, 48))); }
                    if (h == 0 && lane == 0) p.sumsq()[t[z]] = rsum;
                    rstd[z] = 1.0f / sqrtf(rsum * (1.0f / (float)D) + RMS_EPS);
                    row[z] = Ssm + (half * PER_TT + tl[z]) * PER_SP;
#pragma unroll
                    for (int k = 0; k < 4; ++k) pk[z][k] = (f2ord(row[z][li + 32 * k]) & ~127u) | (unsigned)(127 - (li + 32 * k));
                }
#pragma unroll 1
                for (int r = 0; r < 16; ++r) {
#pragma unroll
                    for (int z = 0; z < 2; ++z) {
                        const unsigned m = xrow16_max_u(dpp_rowmax_u(max(max(pk[z][0], pk[z][1]), max(pk[z][2], pk[z][3]))));
#pragma unroll
                        for (int k = 0; k < 4; ++k) pk[z][k] = (pk[z][k] == m) ? 0u : pk[z][k];
                        if (li == r) myidx[z] = 127 - (int)(m & 127u);
                    }
                }
                float myval[2]; unsigned ck[2], myflat[2] = {0u, 0u};
#pragma unroll
                for (int z = 0; z < 2; ++z) {
                    myval[z] = row[z][myidx[z]];
                    const float csum = __shfl(myval[z], ca) + __shfl(myval[z], 32 + (cb & 15));
                    ck[z] = cvalid ? ((f2ord(csum) & ~255u) | (255u - cflat)) : 0u;
                }
#pragma unroll 1
                for (int r = 0; r < 16; ++r) {
#pragma unroll
                    for (int z = 0; z < 2; ++z) {
                        const unsigned m = xrow32_max_u(xrow16_max_u(dpp_rowmax_u(ck[z])));
                        ck[z] = (ck[z] == m) ? 0u : ck[z];
                        if (lane == r) myflat[z] = 255u - (m & 255u);
                    }
                }
#pragma unroll
                for (int z = 0; z < 2; ++z) {
                    const int sa = (int)(myflat[z] >> 4) & 15, sb2 = (int)myflat[z] & 15;
                    const float sc = (__shfl(myval[z], sa) + __shfl(myval[z], 32 + sb2)) * rstd[z];
                    const int ex_id = __shfl(myidx[z], sa) * PE_NK + __shfl(myidx[z], 32 + sb2);
                    const float mx = dpp_rowmax_f(sc);
                    const float ev = expf(sc - mx); const float sm = dpp_rowsum_f(ev);
                    if (lane < 16 && !dry) { p.pli()[t[z] * PE_HK + h * PE_K + lane] = ex_id; p.plg()[t[z] * PE_HK + h * PE_K + lane] = ev / sm; }
                }
            }
            __syncthreads();
        }
    }
}
struct EpiPeer1A {
    static constexpr bool PERM = true, AFTER_DRAIN = false;
    bf16_t* A; unsigned char* Pm; const float* sumsq; int ld; int pad;
    __device__ __forceinline__ void operator()(const pg8::f32x4 (&acc)[2][2][4][2], const pg8::Unit& u, int wr, int wc, int fr, int fq) const {
        const int row0 = u.pm * 256 + wr * 64 + fr, col0 = u.pn * 256 + wc * 32 + 8 * fq;
#pragma unroll
        for (int ai = 0; ai < 2; ++ai)
#pragma unroll
            for (int m = 0; m < 4; ++m) {
                const int row = row0 + ai * 128 + m * 16;
                const float sc = (1.0f / (F8S_X * F8S_U)) / sqrtf(sumsq[row] * (1.0f / (float)D) + RMS_EPS);
#pragma unroll
                for (int bj = 0; bj < 2; ++bj) {
                    const size_t o = (size_t)row * ld + col0 + bj * 128;
                    const pg8::f32x4 v0 = acc[ai][bj][m][0] * sc, v1 = acc[ai][bj][m][1] * sc;
                    pg8::u32x4 wv; wv.x = pk2(v0[0], v0[1]); wv.y = pk2(v0[2], v0[3]); wv.z = pk2(v1[0], v1[1]); wv.w = pk2(v1[2], v1[3]);
                    *(pg8::u32x4*)(A + o) = wv;
                    *(uint2*)(Pm + o) = make_uint2(0u, 0u);
                }
            }
    }
};
DEVFN void ph_pe_apply(const P& p, LAS unsigned char* lds) {
    const int tid = tid_fresh(), w = tid >> 6, lane = tid & 63;
    LAS int* ids = (LAS int*)(lds + w * 1024); LAS float* gs = (LAS float*)(lds + w * 1024 + 512);
    for (int t = bid_fresh() + (int)gridDim.x * w; t < T; t += 8 * (int)gridDim.x) {
        const int e0 = p.pli()[(size_t)t * PE_HK + lane], e1 = p.pli()[(size_t)t * PE_HK + 64 + lane];
        const float g0 = p.plg()[(size_t)t * PE_HK + lane], g1 = p.plg()[(size_t)t * PE_HK + 64 + lane];
        ids[lane] = e0; ids[64 + lane] = e1; gs[lane] = g0; gs[64 + lane] = g1;
        asm volatile("s_waitcnt lgkmcnt(0)" ::: "memory");
        float s0 = 0.f, s1 = 0.f; bool f0 = true, f1 = true;
#pragma unroll 8
        for (int j = 0; j < PE_HK; ++j) {
            const int idj = ids[j]; const float gj = gs[j];
            if (idj == e0) { s0 += gj; if (j < lane) f0 = false; }
            if (idj == e1) { s1 += gj; if (j < 64 + lane) f1 = false; }
        }
        if (f0) { const float a = bf2f(p.A16()[(size_t)t * PE_E + e0]); p.P8()[(size_t)t * PE_E + e0] = (unsigned char)(pk4f8(s0 * gelu_erff_(a) * F8S_P, 0.f, 0.f, 0.f) & 0xffu); }
        if (f1) { const float a = bf2f(p.A16()[(size_t)t * PE_E + e1]); p.P8()[(size_t)t * PE_E + e1] = (unsigned char)(pk4f8(s1 * gelu_erff_(a) * F8S_P, 0.f, 0.f, 0.f) & 0xffu); }
        asm volatile("s_waitcnt lgkmcnt(0)" ::: "memory");
    }
}
struct EpiPeer1F8 {
    static constexpr bool PERM = true, AFTER_DRAIN = false;
    unsigned char* Pm; const bf16_t* G; const float* sumsq; int ld; int pad;
    __device__ __forceinline__ void operator()(const pg8::f32x4 (&acc)[2][2][4][2], const pg8::Unit& u, int wr, int wc, int fr, int fq) const {
        const int row0 = u.pm * 256 + wr * 64 + fr, col0 = u.pn * 256 + wc * 32 + 8 * fq;
#pragma unroll
        for (int ai = 0; ai < 2; ++ai) {
            pg8::u32x4 gw[4][2]; float ssq[4];
#pragma unroll
            for (int m = 0; m < 4; ++m) {
                const int row = row0 + ai * 128 + m * 16; ssq[m] = sumsq[row];
#pragma unroll
                for (int bj = 0; bj < 2; ++bj) gw[m][bj] = *(const pg8::u32x4*)(G + (size_t)row * ld + col0 + bj * 128);
            }
            asm volatile("" ::: "memory");
#pragma unroll
            for (int m = 0; m < 4; ++m) {
                const int row = row0 + ai * 128 + m * 16;
                const float sc = (1.0f / (F8S_X * F8S_U)) / sqrtf(ssq[m] * (1.0f / (float)D) + RMS_EPS);
#pragma unroll
                for (int bj = 0; bj < 2; ++bj) {
                    const size_t o = (size_t)row * ld + col0 + bj * 128;
                    const pg8::u32x4 g4 = gw[m][bj];
                    const pg8::f32x4 v0 = acc[ai][bj][m][0] * sc, v1 = acc[ai][bj][m][1] * sc;
                    const pg8::f32x2 a = pg8::gelu_pk((pg8::f32x2){v0[0], v0[1]}), b = pg8::gelu_pk((pg8::f32x2){v0[2], v0[3]}),
                                     c = pg8::gelu_pk((pg8::f32x2){v1[0], v1[1]}), d = pg8::gelu_pk((pg8::f32x2){v1[2], v1[3]});
                    const unsigned w0 = pk4f8(a.x * F8S_P * __uint_as_float(g4.x << 16), a.y * F8S_P * __uint_as_float(g4.x & 0xffff0000u), b.x * F8S_P * __uint_as_float(g4.y << 16), b.y * F8S_P * __uint_as_float(g4.y & 0xffff0000u));
                    const unsigned w1 = pk4f8(c.x * F8S_P * __uint_as_float(g4.z << 16), c.y * F8S_P * __uint_as_float(g4.z & 0xffff0000u), d.x * F8S_P * __uint_as_float(g4.w << 16), d.y * F8S_P * __uint_as_float(g4.w & 0xffff0000u));
                    *(uint2*)(Pm + o) = make_uint2(w0, w1);
                }
            }
        }
    }
};
struct EpiF32C {
    static constexpr bool PERM = false, AFTER_DRAIN = false;
    float* C; const float* R; float cs; int ld;
    __device__ __forceinline__ void operator()(const pg8::f32x4 (&acc)[2][2][4][2], const pg8::Unit& u, int wr, int wc, int fr, int fq) const {
        const int row0 = u.pm * 256 + wr * 64 + fr, col0 = u.pn * 256 + wc * 32 + 4 * fq;
#pragma unroll
        for (int ai = 0; ai < 2; ++ai)
#pragma unroll
            for (int m = 0; m < 4; ++m)
#pragma unroll
                for (int bj = 0; bj < 2; ++bj)
#pragma unroll
                    for (int n = 0; n < 2; ++n) {
                        const size_t o = (size_t)(row0 + ai * 128 + m * 16) * ld + col0 + bj * 128 + n * 16;
                        *(pg8::f32x4*)(C + o) = acc[ai][bj][m][n] * cs + *(const pg8::f32x4*)(R + o);
                    }
    }
};
struct EpiResid {
    static constexpr bool PERM = false, AFTER_DRAIN = false;
    bf16_t* Xb; unsigned char* X8; float* part; float cs; int ld;
    __device__ __forceinline__ void operator()(const pg8::f32x4 (&acc)[2][2][4][2], const pg8::Unit& u, int wr, int wc, int fr, int fq) const {
        static_assert(D == 4096, "64 partial sums per row = 16 column tiles x 4 waves");
        const int row0 = u.pm * 256 + wr * 64 + fr, col0 = u.pn * 256 + wc * 32 + 4 * fq;
#pragma unroll
        for (int ai = 0; ai < 2; ++ai) {
            uint2 rv[4][2][2];
#pragma unroll
            for (int m = 0; m < 4; ++m)
#pragma unroll
                for (int bj = 0; bj < 2; ++bj)
#pragma unroll
                    for (int n = 0; n < 2; ++n) rv[m][bj][n] = *(const uint2*)(Xb + (size_t)(row0 + ai * 128 + m * 16) * ld + col0 + bj * 128 + n * 16);
            asm volatile("" ::: "memory");
#pragma unroll
            for (int m = 0; m < 4; ++m) {
                const int row = row0 + ai * 128 + m * 16; float ss = 0.f;
#pragma unroll
                for (int bj = 0; bj < 2; ++bj)
#pragma unroll
                    for (int n = 0; n < 2; ++n) {
                        const size_t o = (size_t)row * ld + col0 + bj * 128 + n * 16;
                        const uint2 rw = rv[m][bj][n];
                        const pg8::f32x4 r = (pg8::f32x4){__uint_as_float(rw.x << 16), __uint_as_float(rw.x & 0xffff0000u), __uint_as_float(rw.y << 16), __uint_as_float(rw.y & 0xffff0000u)};
                        const pg8::f32x4 v = acc[ai][bj][m][n] * cs + r;
                        *(uint2*)(Xb + o) = make_uint2(pk2(v[0], v[1]), pk2(v[2], v[3]));
                        if (X8) *(unsigned*)(X8 + o) = pk4f8(v[0] * F8S_X, v[1] * F8S_X, v[2] * F8S_X, v[3] * F8S_X);
                        ss += (v[0] * v[0] + v[1] * v[1]) + (v[2] * v[2] + v[3] * v[3]);
                    }
                ss += __shfl_xor(ss, 16); ss += __shfl_xor(ss, 32);
                if (fq == 0) part[(size_t)row * 64 + u.pn * 4 + wc] = ss;
            }
        }
    }
};
template <bool HAS8> struct EpiResidP {
    static constexpr bool PERM = true, AFTER_DRAIN = false;
    bf16_t* Xb; unsigned char* X8; float* part; float cs; int ld;
    __device__ __forceinline__ void operator()(const pg8::f32x4 (&acc)[2][2][4][2], const pg8::Unit& u, int wr, int wc, int fr, int fq) const {
        static_assert(D == 4096, "64 partial sums per row = 16 column tiles x 4 waves");
        const int row0 = u.pm * 256 + wr * 64 + fr, col0 = u.pn * 256 + wc * 32 + 8 * fq;
#pragma unroll
        for (int ai = 0; ai < 2; ++ai)
#pragma unroll
          for (int mh = 0; mh < 2; ++mh) {
            pg8::u32x4 rv[4][2];
#pragma unroll
            for (int m = 2 * mh; m < 2 * mh + 2; ++m)
#pragma unroll
                for (int bj = 0; bj < 2; ++bj) rv[m][bj] = *(const pg8::u32x4*)(Xb + (size_t)(row0 + ai * 128 + m * 16) * ld + col0 + bj * 128);
            asm volatile("" ::: "memory");
#pragma unroll
            for (int m = 2 * mh; m < 2 * mh + 2; ++m) {
                const int row = row0 + ai * 128 + m * 16; float ss = 0.f;
#pragma unroll
                for (int bj = 0; bj < 2; ++bj) {
                    const size_t o = (size_t)row * ld + col0 + bj * 128;
                    const pg8::u32x4 rw = rv[m][bj];
                    const pg8::f32x4 r0 = (pg8::f32x4){__uint_as_float(rw.x << 16), __uint_as_float(rw.x & 0xffff0000u), __uint_as_float(rw.y << 16), __uint_as_float(rw.y & 0xffff0000u)};
                    const pg8::f32x4 r1 = (pg8::f32x4){__uint_as_float(rw.z << 16), __uint_as_float(rw.z & 0xffff0000u), __uint_as_float(rw.w << 16), __uint_as_float(rw.w & 0xffff0000u)};
                    const pg8::f32x4 v0 = acc[ai][bj][m][0] * cs + r0, v1 = acc[ai][bj][m][1] * cs + r1;
                    pg8::u32x4 wv; wv.x = pk2(v0[0], v0[1]); wv.y = pk2(v0[2], v0[3]); wv.z = pk2(v1[0], v1[1]); wv.w = pk2(v1[2], v1[3]);
                    *(pg8::u32x4*)(Xb + o) = wv;
                    if constexpr (HAS8) *(uint2*)(X8 + o) = make_uint2(pk4f8(v0[0] * F8S_X, v0[1] * F8S_X, v0[2] * F8S_X, v0[3] * F8S_X), pk4f8(v1[0] * F8S_X, v1[1] * F8S_X, v1[2] * F8S_X, v1[3] * F8S_X));
                    ss += ((v0[0] * v0[0] + v0[1] * v0[1]) + (v0[2] * v0[2] + v0[3] * v0[3])) + ((v1[0] * v1[0] + v1[1] * v1[1]) + (v1[2] * v1[2] + v1[3] * v1[3]));
                }
                ss += __shfl_xor(ss, 16); ss += __shfl_xor(ss, 32);
                if (fq == 0) part[(size_t)row * 64 + u.pn * 4 + wc] = ss;
            }
        }
    }
};
DEVFN void b_ssq_reduce(const P& p, const int l, long gid) {
    const float* q = p.ssp() + (size_t)gid * 64; float s = 0.f;
    for (int i = 0; i < 64; ++i) s += q[i];
    p.sumsq()[gid] = s;
}
template <bool PERM_> struct EpiNull {
    static constexpr bool PERM = PERM_, AFTER_DRAIN = false;
    int dummy, pad;
    __device__ __forceinline__ void operator()(const pg8::f32x4 (&acc)[2][2][4][2], const pg8::Unit& u, int wr, int wc, int fr, int fq) const {
#pragma unroll
        for (int ai = 0; ai < 2; ++ai)
#pragma unroll
            for (int bj = 0; bj < 2; ++bj)
#pragma unroll
                for (int m = 0; m < 4; ++m)
#pragma unroll
                    for (int n = 0; n < 2; ++n) asm volatile("" :: "v"(acc[ai][bj][m][n]));
    }
};
struct EpiBf16S {
    static constexpr bool PERM = true, AFTER_DRAIN = false;
    bf16_t* O; const float* sumsq; int ld; int pad;
    __device__ __forceinline__ void operator()(const pg8::f32x4 (&acc)[2][2][4][2], const pg8::Unit& u, int wr, int wc, int fr, int fq) const {
        const int row0 = u.pm * 256 + wr * 64 + fr, col0 = u.pn * 256 + wc * 32 + 8 * fq;
#pragma unroll
        for (int ai = 0; ai < 2; ++ai)
#pragma unroll
            for (int m = 0; m < 4; ++m) {
                const int row = row0 + ai * 128 + m * 16;
                const float sc = sumsq ? 1.0f / sqrtf(sumsq[row] * (1.0f / (float)D) + RMS_EPS) : 1.0f;
#pragma unroll
                for (int bj = 0; bj < 2; ++bj) {
                    const pg8::f32x4 v0 = acc[ai][bj][m][0] * sc, v1 = acc[ai][bj][m][1] * sc;
                    pg8::u32x4 wv; wv.x = pk2(v0[0], v0[1]); wv.y = pk2(v0[2], v0[3]); wv.z = pk2(v1[0], v1[1]); wv.w = pk2(v1[2], v1[3]);
                    *(pg8::u32x4*)(O + (size_t)row * ld + col0 + bj * 128) = wv;
                }
            }
    }
};
DEVFN void b_cvt_plain(const float* __restrict__ src, bf16_t* __restrict__ dst, long gid) {
    const size_t i = (size_t)gid * 8; const float4 a = *(const float4*)(src + i), b = *(const float4*)(src + i + 4);
    *(uint4*)(dst + i) = make_uint4(pk2(a.x, a.y), pk2(a.z, a.w), pk2(b.x, b.y), pk2(b.z, b.w));
}

#define XB_TMO      128
#define XB_XCNT(j)  (256  + 64 * (j))
#define XB_XSUB(j)  (1280 + 64 * (j))
#define XB_XGEN(j)  (2304 + 64 * (j))
#define XB_TOP      3328
#define XB_TOPGEN   3392
#define XCD_BAR_WORDS 3456
#define XB_SPIN_CAP (1u << 18)

__device__ __forceinline__ unsigned xb_ld(unsigned* p)              { return __hip_atomic_load(p, __ATOMIC_RELAXED, __HIP_MEMORY_SCOPE_AGENT); }
__device__ __forceinline__ unsigned xb_add(unsigned* p, unsigned v) { return __hip_atomic_fetch_add(p, v, __ATOMIC_RELAXED, __HIP_MEMORY_SCOPE_AGENT); }
__device__ __forceinline__ unsigned xb_xcc_id() { return (unsigned)__builtin_amdgcn_s_getreg((3 << 11) | 20) & 0xFu; }
#define XB_SPIN(cond, bar) do { unsigned _sp = 0; while (cond) { __builtin_amdgcn_s_sleep(1); \
    if ((++_sp & 255u) == 0u) { if (xb_ld(&(bar)[XB_TMO])) break; if (_sp > XB_SPIN_CAP) { atomicAdd(&(bar)[XB_TMO], 1u); break; } } } } while (0)

struct XcdBarrier {
    unsigned* bar; unsigned x;
    volatile LAS unsigned* st;
};

__device__ __forceinline__ XcdBarrier xcd_barrier_post(unsigned* bar, volatile LAS unsigned* st) {
    XcdBarrier b; b.bar = bar; b.x = xb_xcc_id(); b.st = st;
    if (threadIdx.x == 0) (void)xb_add(&bar[XB_XCNT(b.x)], 1u);
    return b;
}
__device__ __forceinline__ void xcd_barrier_complete(unsigned* bar, unsigned x, unsigned& nloc, unsigned& nx) {
    const unsigned G = gridDim.x * gridDim.y * gridDim.z;
    unsigned sum, cnt, mine, sp = 0u;
    for (;;) {
        sum = 0u; cnt = 0u; mine = 0u;
#pragma unroll
        for (unsigned j = 0; j < 16; ++j) { const unsigned c = xb_ld(&bar[XB_XCNT(j)]); sum += c; cnt += (c > 0u) ? 1u : 0u; mine = (j == x) ? c : mine; }
        if (sum == G) break;
        __builtin_amdgcn_s_sleep(1);
        if ((++sp & 255u) == 0u) { if (xb_ld(&bar[XB_TMO])) break; if (sp > XB_SPIN_CAP) { atomicAdd(&bar[XB_TMO], 1u); break; } }
    }
    nloc = mine > 0u ? mine : 1u; nx = cnt > 0u ? cnt : 1u;
}

__device__ __forceinline__ void xcd_barrier(const XcdBarrier& b) {
    asm volatile("s_waitcnt vmcnt(0)" ::: "memory");
    __syncthreads();
    if (threadIdx.x == 0) {
        unsigned* bar = b.bar;
        __builtin_amdgcn_s_waitcnt(0);
        unsigned nloc = b.st[0], nx = b.st[1];
        if (nloc == 0u) { xcd_barrier_complete(bar, b.x, nloc, nx); b.st[0] = nloc; b.st[1] = nx; }
        const unsigned old = xb_add(&bar[XB_XSUB(b.x)], 1u);
        const unsigned gen = old / nloc;
        if (old + 1u == (gen + 1u) * nloc) {
            __builtin_amdgcn_fence(__ATOMIC_RELEASE, "agent");
            asm volatile("s_waitcnt vmcnt(0)" ::: "memory");
            const unsigned og = xb_add(&bar[XB_TOP], 1u);
            const unsigned tg = og / nx;
            if (og + 1u == (tg + 1u) * nx) xb_add(&bar[XB_TOPGEN], 1u);
            else XB_SPIN(xb_ld(&bar[XB_TOPGEN]) == tg, bar);
            __builtin_amdgcn_fence(__ATOMIC_ACQUIRE, "agent");
            xb_add(&bar[XB_XGEN(b.x)], 1u);
            asm volatile("s_waitcnt vmcnt(0)" ::: "memory");
        } else {
            XB_SPIN(xb_ld(&bar[XB_XGEN(b.x)]) == gen, bar);
            __builtin_amdgcn_fence(__ATOMIC_ACQUIRE, "agent");
            asm volatile("s_waitcnt vmcnt(0)" ::: "memory");
        }
    }
    __syncthreads();
}


#define VLOOP_SUB(n, first, cnt, call) do { const long _n = (long)(n); const int _vb = bid_fresh() - (first); const int _t = tid_fresh(); if (_vb >= 0 && _vb < (cnt)) \
    for (long _w = (long)(_t >> 6) * (cnt) + _vb; _w * 64 < _n; _w += 8L * (cnt)) { const long gid = _w * 64 + (_t & 63); if (gid < _n) { call; } } } while (0)
#define VLOOP(n, rot, wrot, call) do { const long _n = (long)(n); const int _G = (int)gridDim.x; const int _vb = (int)((bid_fresh() + _G - ((rot) % _G)) % _G); const int _t = tid_fresh(); \
    for (long _w = (long)(((_t >> 6) + (wrot)) & 7) * _G + _vb; _w * 64 < _n; _w += 8L * _G) { const long gid = _w * 64 + (_t & 63); if (gid < _n) { call; } } } while (0)

template <bool F8 = false> DEVFN void ph_cvt_t(LAS float* tile, const float* __restrict__ src, int N, int K, bf16_t* __restrict__ dst, int Npad, const float* __restrict__ g, const float f8scale = 1.f) {
    const int tid = tid_fresh(), ntn = Npad / 128, ntk = K / 128, nt = ntn * ntk, ty = tid >> 5, tx = tid & 31, nn = tid >> 2, ks = (tid & 3) * 32;
    float4 v[8];
#define CVT_LOAD(ti_) do { const int _n0 = ((ti_) % ntn) * 128, _k0 = ((ti_) / ntn) * 128; _Pragma("unroll") for (int r = 0; r < 8; ++r) { const int kk = ty + 16 * r, n = _n0 + tx * 4; \
        v[r] = make_float4(0.f, 0.f, 0.f, 0.f); if (n + 4 <= N) v[r] = *(const float4*)(src + (size_t)(_k0 + kk) * N + n); } } while (0)
    int ti = bid_fresh();
    if (ti < nt) CVT_LOAD(ti);
    for (; ti < nt; ti += gridDim.x) {
        const int n0 = (ti % ntn) * 128, k0 = (ti / ntn) * 128;
#pragma unroll
        for (int r = 0; r < 8; ++r) { const int kk = ty + 16 * r; const float gq = g ? g[k0 + kk] : 1.0f; tile[kk * 129 + tx * 4 + 0] = v[r].x * gq; tile[kk * 129 + tx * 4 + 1] = v[r].y * gq; tile[kk * 129 + tx * 4 + 2] = v[r].z * gq; tile[kk * 129 + tx * 4 + 3] = v[r].w * gq; }
        if (ti + (int)gridDim.x < nt) CVT_LOAD(ti + (int)gridDim.x);
        __syncthreads();
        if constexpr (F8) {
            unsigned w[8];
#pragma unroll
            for (int i = 0; i < 8; ++i) w[i] = pk4f8(tile[(ks + 4 * i) * 129 + nn] * f8scale, tile[(ks + 4 * i + 1) * 129 + nn] * f8scale, tile[(ks + 4 * i + 2) * 129 + nn] * f8scale, tile[(ks + 4 * i + 3) * 129 + nn] * f8scale);
            uint4* d = (uint4*)((unsigned char*)dst + (size_t)(n0 + nn) * K + k0 + ks);
            d[0] = make_uint4(w[0], w[1], w[2], w[3]); d[1] = make_uint4(w[4], w[5], w[6], w[7]);
        } else {
            unsigned w[16];
#pragma unroll
            for (int i = 0; i < 16; ++i) w[i] = pack2bf(tile[(ks + 2 * i) * 129 + nn], tile[(ks + 2 * i + 1) * 129 + nn]);
            uint4* d = (uint4*)(dst + (size_t)(n0 + nn) * K + k0 + ks);
            d[0] = make_uint4(w[0], w[1], w[2], w[3]); d[1] = make_uint4(w[4], w[5], w[6], w[7]); d[2] = make_uint4(w[8], w[9], w[10], w[11]); d[3] = make_uint4(w[12], w[13], w[14], w[15]);
        }
        __syncthreads();
    }
#undef CVT_LOAD
}
DEVFN void ph_xprep(const float* __restrict__ x, bf16_t* __restrict__ xb, float* __restrict__ sumsq, unsigned char* __restrict__ xq8 = nullptr) {
    const int tid = tid_fresh(), lane = tid & 63;
    for (int row = (int)(tid >> 6) * (int)gridDim.x + bid_fresh(); row < T; row += 8 * (int)gridDim.x) {
        const float4* r = (const float4*)(x + (size_t)row * D); uint2* o = (uint2*)(xb + (size_t)row * D); float s = 0.f;
        for (int i = lane; i < D / 4; i += 64) { const float4 v = r[i]; s += v.x * v.x + v.y * v.y + v.z * v.z + v.w * v.w; o[i] = make_uint2(pack2bf(v.x, v.y), pack2bf(v.z, v.w));
            if (xq8) ((unsigned*)(xq8 + (size_t)row * D))[i] = pk4f8(v.x * F8S_X, v.y * F8S_X, v.z * F8S_X, v.w * F8S_X); }
        for (int off = 32; off >= 1; off >>= 1) s += __shfl_xor(s, off);
        if (lane == 0) sumsq[row] = s;
    }
}
DEVFN void ph_final(const bf16_t* __restrict__ x, const float* __restrict__ g, float* __restrict__ out) {
    const int tid = tid_fresh(), lane = tid & 63;
    for (int row = (int)(tid >> 6) * (int)gridDim.x + bid_fresh(); row < T; row += 8 * (int)gridDim.x) {
        const uint2* r = (const uint2*)(x + (size_t)row * D); float4* o = (float4*)(out + (size_t)row * D); float s = 0.f;
        for (int i = lane; i < D / 4; i += 64) { const uint2 w = r[i]; const float a = __uint_as_float(w.x << 16), b = __uint_as_float(w.x & 0xffff0000u), c = __uint_as_float(w.y << 16), d = __uint_as_float(w.y & 0xffff0000u); s += a * a + b * b + c * c + d * d; }
        for (int off = 32; off >= 1; off >>= 1) s += __shfl_xor(s, off);
        const float rs = 1.0f / sqrtf(s * (1.0f / (float)D) + RMS_EPS);
        for (int i = lane; i < D / 4; i += 64) { const uint2 w = r[i]; const float4 gg = ((const float4*)g)[i];
            o[i] = make_float4(__uint_as_float(w.x << 16) * rs * gg.x, __uint_as_float(w.x & 0xffff0000u) * rs * gg.y, __uint_as_float(w.y << 16) * rs * gg.z, __uint_as_float(w.y & 0xffff0000u) * rs * gg.w); }
    }
}
template <bool SP2, class Epi, bool F8 = false> DEVFN void ph_gemm(LAS unsigned char* lds, const bf16_t* A, const bf16_t* Bt, int M, int N, int K, const Epi& E, const int wgm = 4) {
    asm volatile("" : "+s"(K), "+s"(M), "+s"(N));
    pg8::Gemm g; g.A = A; g.Bt = Bt; g.M = M; g.N = N; g.K = K;
    pg8::StaticOrder So; So.init(M, N, (int)gridDim.x, bid_fresh(), wgm);
    pg8::gemm_phase<Epi, pg8::StaticOrder, true, SP2, F8>(lds, g, So, E);
}

#ifndef WGM_P1
#define WGM_P1 4
#endif
#ifndef WGM_P5
#define WGM_P5 4
#endif
#ifndef WGM_P8
#define WGM_P8 4
#endif
#ifndef WGM_P9
#define WGM_P9 8
#endif
#ifndef MK_LAUNCHES
#define MK_LAUNCHES 1
#endif
constexpr int NPH = 11, NPH_ALL = NL * NPH + 1;
constexpr int LDS_BYTES = pg8::STAGE_BYTES + 64;
struct Args { P p; int ph_lo, ph_hi, use_bar, pad; };

DEVFN bool in_range(int k, const int lo, const int hi) { asm volatile("" : "+s"(k)); return lo <= k && k < hi; }
__global__ void __launch_bounds__(512, 2) fwd(Args a) {
    extern __shared__ __attribute__((aligned(16))) unsigned char lds_raw[];
    LAS unsigned char* lds = (LAS unsigned char*)lds_raw;
    volatile LAS unsigned* st = (volatile LAS unsigned*)(lds + pg8::STAGE_BYTES);
    if (threadIdx.x == 0) { st[0] = 0u; st[1] = 0u; st[2] = 0u; st[3] = 0u; }
    __syncthreads();
    XcdBarrier bar; bar.bar = a.p.bar(); bar.x = 0; bar.st = st;
    if (a.use_bar) bar = xcd_barrier_post(a.p.bar(), st);
    const P& p = a.p;
    const int lo = a.ph_lo, hi = a.ph_hi;
    LAS float* tile = (LAS float*)lds;
#define IN(k) in_range((k), lo, hi)
#define SEAM(k) do { if (IN((k) + 1)) xcd_barrier(bar); } while (0)
#ifndef PROBE_MASK
#define PROBE_MASK 0
#endif
#ifndef PROBE_SUB
#define PROBE_SUB 0
#endif
#define RX(n, ...) { __VA_ARGS__ if (PROBE_SUB == (n)) { __syncthreads(); __VA_ARGS__ } }
#define PH(k, ...) if (IN(b + (k))) { int l = lay; P pl_ = a.p; asm volatile("" : "+s"(l), "+s"(pl_.ws));     \
    const P& p = pl_; _Pragma("unroll 1") for (int _rep = 0; _rep <= ((PROBE_MASK >> (k)) & 1); ++_rep) { __VA_ARGS__ if (_rep < ((PROBE_MASK >> (k)) & 1)) xcd_barrier(bar); } SEAM(b + (k)); }
    for (int lay = 0; lay < NL; ++lay) {
        const int b = lay * NPH;
        PH(0,
            ph_cvt_t(tile, p.w_in + (size_t)l * D * INW, INW, D, p.WinT(), PLD, p.norm1_g + (size_t)l * D);
            ph_cvt_t(tile, p.w_out + (size_t)l * D * D, D, D, p.WoutT(), D, nullptr);
            ph_cvt_t(tile, p.peer_wq + (size_t)l * D * PE_QW, PE_QW, D, p.WqT(), PE_QW, p.norm2_g + (size_t)l * D);
            ph_cvt_t(tile, p.s5_w_glu + (size_t)l * GW * GW, GW, GW, p.GluT(), GW, nullptr);
            ph_cvt_t<true>(tile, p.peer_v + (size_t)l * PE_E * D, D, PE_E, (bf16_t*)p.Vt8(), D, nullptr, F8S_V);
            ph_cvt8_stream(p.peer_u + (size_t)l * PE_E * D, p.U8(), p.norm2_g + (size_t)l * D, D, F8S_U, (long)PE_E * D / 8);
            VLOOP((long)PE_H * 2 * PE_NK * PE_DH / 8, 0, 0, b_cvt_plain(p.peer_subkeys + (size_t)l * PE_H * 2 * PE_NK * PE_DH, p.skb(), gid));
            VLOOP((long)LRU_NBLK * 256 * 16, 0, 0, b_lru_wprep2(p, l, gid));
            VLOOP((long)S5_GP, 0, 0, b_s5_pre2(p, l, gid)); VLOOP((long)S5_GP * (S5_L + 1), 0, 1, b_s5_pw(p, l, gid));
            if (l == 0) ph_xprep(p.x, p.xbf(), p.sumsq()); else VLOOP((long)T, 0, 0, b_ssq_reduce(p, l, gid));)
        PH(1,
            { EpiBf16S e; e.O = p.pjb(); e.sumsq = p.sumsq(); e.ld = PLD; e.pad = 0; ph_gemm<true>(lds, p.xbf(), p.WinT(), T, PLD, D, e, WGM_P1); }
#if PROBE_SUB == 21
            { xcd_barrier(bar); EpiNull<true> e; e.dummy = 0; e.pad = 0; ph_gemm<true>(lds, p.xbf(), p.WinT(), T, PLD, D, e); }
#endif
            { constexpr int NU = (T / 256) * (PLD / 256), FIRST = NU % 256, CNT = 256 - FIRST;
              if (gridDim.x == 256 && CNT >= 96) { ph_s5_ktoep(p, l, lds, FIRST, 64); VLOOP_SUB((long)S5_G * S5_P2 * 128, FIRST + 64, CNT - 64, b_s5_wend(p, l, gid)); VLOOP_SUB((long)S5_G * S5_K * 16, FIRST + 64, CNT - 64, b_s5_mc(p, l, gid)); }
              else { VLOOP((long)S5_G * S5_L * 256, 0, 0, b_s5_ktoep(p, l, gid)); VLOOP((long)S5_G * S5_P2 * 128, 0, 0, b_s5_wend(p, l, gid)); VLOOP((long)S5_G * S5_K * 16, 0, 0, b_s5_mc(p, l, gid)); } })
        PH(2,
            RX(1, VLOOP((long)(T / 4) * (GW / 8), 0, 0, b_lru_conv3(p, l, gid));) RX(2, ph_gla_s1(p, l, lds);) RX(3, ph_s5_e(p, l);) RX(4, ph_mb_prep(p, lds);))
        PH(3,
            { EpiLru2 e; e.LA = p.lA(); e.LB = p.lB(); e.xcb = p.lxcb(); e.ba = p.lru_ba + (size_t)l * GW; e.bx = p.lru_bx + (size_t)l * GW; e.lam = p.lru_lambda + (size_t)l * GW;
              RX(5, { int Kb = LRU_BLK; asm volatile("" : "+s"(Kb)); pg8::Gemm g; g.A = p.lxcb(); g.Bt = p.lruW(); g.M = LRU_NBLK * T; g.N = LRU_NBLK * 256; g.K = Kb; DiagOrder So; So.c = bid_fresh(); So.G = (int)gridDim.x; pg8::gemm_phase<EpiLru2, DiagOrder, true, true, false>(lds, g, So, e); }) }
            RX(6, VLOOP((long)NB * GLA_H * GLA_DV * (GLA_DK / 2), 0, 0, b_gla_s2x(p, l, gid));) RX(7, ph_s5_y(p, l, lds);) RX(8, ph_mb_sel(p);))
        PH(4,
            RX(9, ph_lru_scan(p, l, lds);) { EpiGlu e; e.O = p.mixedb() + 2 * GW; e.Z = p.s5zb(); e.bias = p.s5_b_glu + (size_t)l * GW; e.ldo = D; e.ldz = GW; RX(10, ph_gemm<true>(lds, p.s5zb(), p.GluT(), T, GW, GW, e);) } RX(11, ph_gla_s3(p, l, lds);) RX(12, ph_mb_attn(p, lds);))
        PH(5,
            { EpiResidP<true> e; e.Xb = p.xbf(); e.X8 = p.xq8(); e.part = p.ssp(); e.cs = 1.0f; e.ld = D; ph_gemm<true>(lds, p.mixedb(), p.WoutT(), T, D, D, e, WGM_P5); })
        PH(6,
            { EpiBf16S e; e.O = p.pqb(); e.sumsq = nullptr; e.ld = PE_QW; e.pad = 0; ph_gemm<true>(lds, p.xbf(), p.WqT(), T, PE_QW, D, e); })
#ifdef PROBE_ROUTE
        PH(7, ph_pe_route(p, l, lds, true); xcd_barrier(bar); ph_pe_route(p, l, lds);)
#else
        PH(7,
            ph_pe_route(p, l, lds);)
#endif
        PH(8,
            { EpiPeer1A e; e.A = p.A16(); e.Pm = p.P8(); e.sumsq = p.sumsq(); e.ld = PE_E; e.pad = 0; ph_gemm<true, EpiPeer1A, true>(lds, (const bf16_t*)p.xq8(), (const bf16_t*)p.U8(), T, PE_E, D / 2, e, WGM_P8); })
        PH(9,
            ph_pe_apply(p, lds);)
        PH(10,
            { EpiResidP<false> e; e.Xb = p.xbf(); e.X8 = nullptr; e.part = p.ssp(); e.cs = 1.0f / (F8S_P * F8S_V); e.ld = D; ph_gemm<true, EpiResidP<false>, true>(lds, (const bf16_t*)p.P8(), (const bf16_t*)p.Vt8(), T, D, PE_E / 2, e, WGM_P9); })
    }
    if (IN(NL * NPH)) ph_final(a.p.xbf(), a.p.final_norm_g, a.p.out);
#undef IN
#undef SEAM
#undef PH
}

extern "C" void kernel_launch(void* const* d_in, const int* in_sizes, int n_in, void* d_out, int out_size, void* d_ws, size_t ws_size, hipStream_t stream) {
    Args a{};
    P& p = a.p;
    const float** ins = (const float**)&p.x;
    for (int i = 0; i < 30; ++i) ins[i] = (const float*)d_in[i];
    p.out = (float*)d_out;
    p.ws = (unsigned char*)d_ws;
    if (WSL.end > ws_size) return;
    static int grid = 0;
    if (grid == 0) {
        int dev = 0, cus = 0;
        if (hipGetDevice(&dev) != hipSuccess || hipDeviceGetAttribute(&cus, hipDeviceAttributeMultiprocessorCount, dev) != hipSuccess) { grid = -1; return; }
        if (hipFuncSetAttribute((const void*)fwd, hipFuncAttributeMaxDynamicSharedMemorySize, LDS_BYTES) != hipSuccess) { grid = -1; return; }
        int per_cu = 0;
        if (hipOccupancyMaxActiveBlocksPerMultiprocessor(&per_cu, (const void*)fwd, 512, LDS_BYTES) != hipSuccess || per_cu < 1) { (void)hipGetLastError(); }
        grid = cus;
    }
    if (grid < 0) return;
    (void)hipMemsetAsync((unsigned char*)d_ws + WSL.bar, 0, XCD_BAR_WORDS * sizeof(unsigned), stream);
#if MK_LAUNCHES == 1
    a.ph_lo = 0; a.ph_hi = NPH_ALL; a.use_bar = 1;
    hipLaunchKernelGGL(fwd, dim3(grid), dim3(512), LDS_BYTES, stream, a);
#else
    for (int ph = 0; ph < NPH_ALL; ++ph) { a.ph_lo = ph; a.ph_hi = ph + 1; a.use_bar = 0; hipLaunchKernelGGL(fwd, dim3(grid), dim3(512), LDS_BYTES, stream, a); }
#endif
}
```

```cpp
#include <hip/hip_runtime.h>
#define DEVFN __device__ __forceinline__
#include <math.h>
namespace pg8 {
#define PG8_LAS __attribute__((address_space(3)))
typedef unsigned short bf16_t;
typedef short bf16x8 __attribute__((ext_vector_type(8)));
typedef float f32x4 __attribute__((ext_vector_type(4)));
typedef unsigned u32x4 __attribute__((ext_vector_type(4)));
constexpr int BM = 256, BK = 64, HALF = 128, HTB = HALF * BK * 2  , STAGE_BYTES = 8 * HTB, NXCD = 8, WGM = 8;

__host__ __device__ __forceinline__ int lds_byte(int r, int c) { const int st = (r >> 4) * 2 + (c >> 5), rr = r & 15, cc = c & 31, ob = rr * 64 + cc * 2; return st * 1024 + (ob ^ (((ob >> 9) & 1) << 5)); }
__host__ __device__ __forceinline__ void stage_rc(int b, int& R, int& C) { const int st = b / 1024, sb = b % 1024, swz = sb ^ (((sb >> 9) & 1) << 5); R = (st >> 1) * 16 + swz / 64; C = (st & 1) * 32 + (swz % 64) / 2; }
__host__ __device__ __forceinline__ int perm32(int rho) { const int n = rho >> 4, i = rho & 15; return 8 * (i >> 2) + 4 * n + (i & 3); }

struct Unit { int pm, pn; };
struct Gemm { const bf16_t* A; const bf16_t* Bt; int M, N, K; };

struct StaticOrder {
    int nM, nN, nwg, G, c, wgm;
    __host__ __device__ void init(int M, int N, int G_, int c_, int wgm_ = WGM) { nM = M / BM; nN = N / BM; nwg = nM * nN; G = G_; c = c_; wgm = wgm_; }
    __host__ __device__ bool next(int i, Unit& u) const {
        const long L = (long)i * G + c; if (L >= nwg) return false;
        int wgid = (int)L; { const int q = nwg / NXCD, r = nwg % NXCD, xcd = wgid % NXCD, off = wgid / NXCD; wgid = (xcd < r ? xcd * (q + 1) : r * (q + 1) + (xcd - r) * q) + off; }
        const int nig = wgm * nN, gid = wgid / nig, fm = gid * wgm, gsz = (nM - fm) < wgm ? (nM - fm) : wgm;
        u.pm = fm + ((wgid % nig) % gsz); u.pn = (wgid % nig) / gsz; return true;
    }
    __device__ __forceinline__ void a_ready(const Unit&) const {}
    __device__ __forceinline__ void done(const Unit&) const {}
};
struct CountedOrder : StaticOrder {
    const unsigned* ready; unsigned need; unsigned* tmo;
    __device__ __forceinline__ void a_ready(const Unit& u) const {
        if (threadIdx.x < 64) {
            const unsigned long long t0 = __builtin_amdgcn_s_memrealtime(); unsigned polls = 0;
            while ((unsigned)__builtin_amdgcn_readfirstlane(__hip_atomic_load(ready + 64 * u.pm, __ATOMIC_RELAXED, __HIP_MEMORY_SCOPE_AGENT)) < need) {
                if ((++polls & 255u) == 0u && __builtin_amdgcn_readfirstlane(__hip_atomic_load(tmo, __ATOMIC_RELAXED, __HIP_MEMORY_SCOPE_AGENT)) != 0u) break;
                if (__builtin_amdgcn_s_memrealtime() - t0 > 2000000ull) {
                    if (threadIdx.x == 0) { unsigned expect = 0u; __hip_atomic_compare_exchange_strong(tmo + 1, &expect, 0x600u | (unsigned)(u.pm & 0xff), __ATOMIC_RELAXED, __ATOMIC_RELAXED, __HIP_MEMORY_SCOPE_AGENT); __hip_atomic_store(tmo, 1u, __ATOMIC_RELAXED, __HIP_MEMORY_SCOPE_AGENT); }
                    break; }
                __builtin_amdgcn_s_sleep(2); }
            __builtin_amdgcn_fence(__ATOMIC_ACQUIRE, "agent");
            asm volatile("s_waitcnt vmcnt(0)" ::: "memory");
        }
#if !defined(BROKEN_HOOK_NO_BARRIER)
        asm volatile("" ::: "memory"); __builtin_amdgcn_s_barrier(); asm volatile("" ::: "memory");
#endif
    }
};

__device__ __forceinline__ unsigned cvt_pk_bf16(float lo, float hi) { unsigned r; asm volatile("v_cvt_pk_bf16_f32 %0, %1, %2" : "=v"(r) : "v"(lo), "v"(hi)); return r; }
typedef float f32x2 __attribute__((ext_vector_type(2)));
__device__ __forceinline__ f32x2 gelu_pk(f32x2 v) {
    const f32x2 av = __builtin_elementwise_abs(v), d = av * 0.2316418882f + 1.0f;
    f32x2 t; t.x = __builtin_amdgcn_rcpf(d.x); t.y = __builtin_amdgcn_rcpf(d.y);
    f32x2 q = t * 0.5307027145f + (-0.7265760135f); q = q * t + 0.7107068705f; q = q * t + (-0.142248368f); q = q * t + 0.127414796f; q = q * t;
    const f32x2 s = (v * v) * (-0.72134752044f);
    f32x2 e; e.x = __builtin_amdgcn_exp2f(s.x); e.y = __builtin_amdgcn_exp2f(s.y);
    const f32x2 m = v * (q * e), r = v - m;
    f32x2 o; o.x = v.x < 0.f ? m.x : r.x; o.y = v.y < 0.f ? m.y : r.y; return o;
}

struct EpiF32 {
    static constexpr bool PERM = false, AFTER_DRAIN = false;
    float* C; int ldc; const float* bias;
    __device__ __forceinline__ void operator()(const f32x4 (&acc)[2][2][4][2], const Unit& u, int wr, int wc, int fr, int fq) const {
        const int row0 = u.pm * BM + wr * 64 + fr, col0 = u.pn * BM + wc * 32 + 4 * fq;
        f32x4 bv[2][2];
#pragma unroll
        for (int bj = 0; bj < 2; ++bj)
#pragma unroll
            for (int n = 0; n < 2; ++n) bv[bj][n] = bias ? *(const f32x4*)(bias + col0 + bj * HALF + n * 16) : (f32x4){0.f, 0.f, 0.f, 0.f};
#pragma unroll
        for (int ai = 0; ai < 2; ++ai)
#pragma unroll
            for (int m = 0; m < 4; ++m) { float* rowp = C + (size_t)(row0 + ai * HALF + m * 16) * ldc + col0;
#pragma unroll
                for (int bj = 0; bj < 2; ++bj)
#pragma unroll
                    for (int n = 0; n < 2; ++n) *(f32x4*)(rowp + bj * HALF + n * 16) = acc[ai][bj][m][n] + bv[bj][n]; }
    }
};
template <int ACT  > struct EpiBf16 {
    static constexpr bool PERM = true, AFTER_DRAIN = false;
    bf16_t* O; int ldc; const float* bias; int split_cols; size_t split_stride;
    __device__ __forceinline__ void operator()(const f32x4 (&acc)[2][2][4][2], const Unit& u, int wr, int wc, int fr, int fq) const {
        const int row0 = u.pm * BM + wr * 64 + fr; int colt = u.pn * BM; bf16_t* base = O;
        if (split_cols) { const int t = colt / split_cols; base += (size_t)t * split_stride; colt -= t * split_cols; }
        const int col0 = colt + wc * 32 + 8 * fq, bcol0 = u.pn * BM + wc * 32 + 8 * fq;
        f32x4 bv[2][2];
#pragma unroll
        for (int bj = 0; bj < 2; ++bj)
#pragma unroll
            for (int n = 0; n < 2; ++n) bv[bj][n] = bias ? *(const f32x4*)(bias + bcol0 + bj * HALF + 4 * n) : (f32x4){0.f, 0.f, 0.f, 0.f};
#pragma unroll
        for (int ai = 0; ai < 2; ++ai)
#pragma unroll
            for (int m = 0; m < 4; ++m) { bf16_t* rowp = base + (size_t)(row0 + ai * HALF + m * 16) * ldc + col0;
#pragma unroll
                for (int bj = 0; bj < 2; ++bj) { f32x4 v0 = acc[ai][bj][m][0] + bv[bj][0], v1 = acc[ai][bj][m][1] + bv[bj][1];
                    if (ACT == 1) { f32x2 a = gelu_pk((f32x2){v0[0], v0[1]}), b = gelu_pk((f32x2){v0[2], v0[3]}), c = gelu_pk((f32x2){v1[0], v1[1]}), d = gelu_pk((f32x2){v1[2], v1[3]});
                        v0 = (f32x4){a.x, a.y, b.x, b.y}; v1 = (f32x4){c.x, c.y, d.x, d.y}; }
                    if (ACT == 2) {
#pragma unroll
                        for (int j = 0; j < 4; ++j) { v0[j] = 0.5f * v0[j] * (1.0f + erff(v0[j] * 0.70710678f)); v1[j] = 0.5f * v1[j] * (1.0f + erff(v1[j] * 0.70710678f)); } }
                    u32x4 w; w.x = cvt_pk_bf16(v0[0], v0[1]); w.y = cvt_pk_bf16(v0[2], v0[3]); w.z = cvt_pk_bf16(v1[0], v1[1]); w.w = cvt_pk_bf16(v1[2], v1[3]);
                    *(u32x4*)(rowp + bj * HALF) = w; } }
    }
};
template <class Epi, class Sched, bool ALIGN_EPI = false, bool SP2 = false, bool F8 = false>
__device__ __forceinline__ void gemm_phase(PG8_LAS unsigned char* lds, const Gemm g, const Sched& S, const Epi& E) {
    int tid_ = threadIdx.x; asm volatile("" : "+v"(tid_));
    const int tid = tid_, wid = __builtin_amdgcn_readfirstlane(tid >> 6), lane = tid & 63, wr = wid >> 2, wc = wid & 3, fr = lane & 15, fq = lane >> 4;
    const int K = g.K, nt = K / BK;
    unsigned voffA[2], voffB[2];
#pragma unroll
    for (int i = 0; i < 2; ++i) { int R, C; stage_rc(tid * 16 + i * 8192, R, C); const int Rb = Epi::PERM ? ((R & ~31) + perm32(R & 31)) : R;
        voffA[i] = (unsigned)(R * K + C) * 2u; voffB[i] = (unsigned)(Rb * K + C) * 2u; }
    const size_t kstep = (size_t)(BK * 2);
    const size_t hstep = (size_t)HALF * K * 2;
    const size_t tstep = 2 * hstep;
    const unsigned ldsw = (unsigned)wid * 1024u;
    const int aoff = lds_byte(wr * 64 + fr, fq * 8), boff = lds_byte(wc * 32 + fr, fq * 8);
#define PG8_SA(b, h) (((b) * 2 + (h)) * HTB)
#define PG8_SB(b, h) ((4 + (b) * 2 + (h)) * HTB)
#define PG8_STAGE(bufoff, gbase, voff) do { _Pragma("unroll") for (int _i = 0; _i < 2; ++_i) \
        __builtin_amdgcn_global_load_lds((const unsigned*)((const char*)(gbase) + (voff)[_i]), (PG8_LAS unsigned*)(lds + (bufoff) + ldsw + _i * 8192), 16, 0, 0); } while (0)
#define PG8_LDA(dst, b, h) do { if constexpr (F8) { _Pragma("unroll") for (int m = 0; m < 4; ++m) { const i32x4_ lo_ = *(const PG8_LAS i32x4_*)(lds + PG8_SA(b, h) + aoff + m * 2048), hi_ = *(const PG8_LAS i32x4_*)(lds + PG8_SA(b, h) + aoff + m * 2048 + 1024); \
        dst##8[m] = __builtin_shufflevector(lo_, hi_, 0, 1, 2, 3, 4, 5, 6, 7); } } \
    else { _Pragma("unroll") for (int m = 0; m < 4; ++m) _Pragma("unroll") for (int k = 0; k < 2; ++k) dst[m][k] = *(const PG8_LAS bf16x8*)(lds + PG8_SA(b, h) + aoff + m * 2048 + k * 1024); } } while (0)
#define PG8_LDB(dst, b, h) do { if constexpr (F8) { _Pragma("unroll") for (int n = 0; n < 2; ++n) { const i32x4_ lo_ = *(const PG8_LAS i32x4_*)(lds + PG8_SB(b, h) + boff + n * 2048), hi_ = *(const PG8_LAS i32x4_*)(lds + PG8_SB(b, h) + boff + n * 2048 + 1024); \
        dst##8[n] = __builtin_shufflevector(lo_, hi_, 0, 1, 2, 3, 4, 5, 6, 7); } } \
    else { _Pragma("unroll") for (int n = 0; n < 2; ++n) _Pragma("unroll") for (int k = 0; k < 2; ++k) dst[n][k] = *(const PG8_LAS bf16x8*)(lds + PG8_SB(b, h) + boff + n * 2048 + k * 1024); } } while (0)
#define PG8_MMA(ai, bj, At, Bt) do { __builtin_amdgcn_s_setprio(1); _Pragma("unroll") for (int m = 0; m < 4; ++m) _Pragma("unroll") for (int n = 0; n < 2; ++n) { \
        if constexpr (F8) asm volatile("v_mfma_f32_16x16x128_f8f6f4 %0, %1, %2, %0" : "+v"(acc[ai][bj][m][n]) : "v"(Bt##8[n]), "v"(At##8[m]));     \
        else { _Pragma("unroll") for (int k = 0; k < 2; ++k) acc[ai][bj][m][n] = __builtin_amdgcn_mfma_f32_16x16x32_bf16(Bt[n][k], At[m][k], acc[ai][bj][m][n], 0, 0, 0); } } \
        __builtin_amdgcn_s_setprio(0); } while (0)
#define PG8_WAIT_V(n) asm volatile("s_waitcnt vmcnt(" #n ")" ::: "memory")
#define PG8_WAIT_L(n) asm volatile("s_waitcnt lgkmcnt(" #n ")" ::: "memory")
#define PG8_BAR __builtin_amdgcn_s_barrier()
#define PG8_SCHED __builtin_amdgcn_sched_barrier(0)
    Unit cur, nxt; int ui = 0;
    if (!S.next(0, cur)) return;
    f32x4 acc[2][2][4][2];
    float zf_ = 0.f; asm volatile("" : "+v"(zf_));
#pragma unroll
    for (int a = 0; a < 2; ++a)
#pragma unroll
        for (int b = 0; b < 2; ++b)
#pragma unroll
            for (int m = 0; m < 4; ++m)
#pragma unroll
                for (int n = 0; n < 2; ++n) acc[a][b][m][n] = (f32x4){zf_, zf_, zf_, zf_};
    typedef int i32x4_ __attribute__((ext_vector_type(4))); typedef int i32x8_ __attribute__((ext_vector_type(8)));
    bf16x8 At[4][2], B0[2][2], B1[2][2]; i32x8_ At8[4], B08[2], B18[2];
    const char* cA = (const char*)g.A + (size_t)cur.pm * tstep; const char* cB = (const char*)g.Bt + (size_t)cur.pn * tstep;
    S.a_ready(cur);
    if constexpr (SP2) {
        PG8_STAGE(PG8_SB(0, 0), cB, voffB); PG8_STAGE(PG8_SB(0, 1), cB + hstep, voffB); PG8_STAGE(PG8_SA(0, 0), cA, voffA); PG8_STAGE(PG8_SA(0, 1), cA + hstep, voffA);
        if (wr == 1) PG8_BAR;
        PG8_WAIT_V(2); PG8_BAR;
        PG8_STAGE(PG8_SB(1, 0), cB + kstep, voffB); PG8_STAGE(PG8_SA(1, 0), cA + kstep, voffA); PG8_STAGE(PG8_SB(1, 1), cB + hstep + kstep, voffB);
        PG8_WAIT_V(6); PG8_BAR;
    } else {
        PG8_STAGE(PG8_SB(0, 0), cB, voffB); PG8_STAGE(PG8_SA(0, 0), cA, voffA); PG8_STAGE(PG8_SB(0, 1), cB + hstep, voffB); PG8_STAGE(PG8_SA(0, 1), cA + hstep, voffA);
        if (wr == 1) PG8_BAR;
        PG8_WAIT_V(4); PG8_BAR;
        PG8_STAGE(PG8_SB(1, 0), cB + kstep, voffB); PG8_STAGE(PG8_SA(1, 0), cA + kstep, voffA); PG8_STAGE(PG8_SB(1, 1), cB + hstep + kstep, voffB);
        PG8_WAIT_V(6); PG8_BAR;
    }
    for (;;) {
        const bool has_next = S.next(ui + 1, nxt);
        const char* nA = has_next ? (const char*)g.A + (size_t)nxt.pm * tstep : cA; const char* nB = has_next ? (const char*)g.Bt + (size_t)nxt.pn * tstep : cB;
        for (int t = 0; t < nt; t += 2) {
            const bool last = (t == nt - 2);
            const char* a1 = cA + (size_t)(t + 1) * kstep;
            const char* a2 = last ? nA : cA + (size_t)(t + 2) * kstep; const char* b2 = last ? nB : cB + (size_t)(t + 2) * kstep;
            const char* a3 = a2 + kstep; const char* b3 = b2 + kstep;
            if (last && has_next) S.a_ready(nxt);
            if constexpr (SP2) {
            PG8_LDB(B0, 0, 0); PG8_LDB(B1, 0, 1); PG8_SCHED; PG8_LDA(At, 0, 0); PG8_STAGE(PG8_SA(1, 1), a1 + hstep, voffA);
            PG8_WAIT_V(8); PG8_WAIT_L(0); PG8_BAR; PG8_MMA(0, 0, At, B0); PG8_MMA(0, 1, At, B1); PG8_BAR; PG8_SCHED;
            PG8_LDA(At, 0, 1); PG8_STAGE(PG8_SB(0, 0), b2, voffB); PG8_STAGE(PG8_SB(0, 1), b2 + hstep, voffB); PG8_STAGE(PG8_SA(0, 0), a2, voffA);
            PG8_WAIT_V(8); PG8_WAIT_L(0); PG8_BAR; PG8_MMA(1, 0, At, B0); PG8_MMA(1, 1, At, B1); PG8_BAR; PG8_SCHED;
            PG8_LDB(B0, 1, 0); PG8_LDB(B1, 1, 1); PG8_SCHED; PG8_LDA(At, 1, 0); PG8_STAGE(PG8_SA(0, 1), a2 + hstep, voffA);
            PG8_WAIT_V(8); PG8_WAIT_L(0); PG8_BAR; PG8_MMA(0, 0, At, B0); PG8_MMA(0, 1, At, B1); PG8_BAR; PG8_SCHED;
            PG8_LDA(At, 1, 1); PG8_STAGE(PG8_SB(1, 0), b3, voffB); PG8_STAGE(PG8_SB(1, 1), b3 + hstep, voffB); PG8_STAGE(PG8_SA(1, 0), a3, voffA);
            PG8_WAIT_V(8); PG8_WAIT_L(0); PG8_BAR; PG8_MMA(1, 0, At, B0); PG8_MMA(1, 1, At, B1); PG8_BAR; PG8_SCHED;
            } else {
            PG8_LDB(B0, 0, 0); PG8_SCHED; PG8_LDA(At, 0, 0); PG8_STAGE(PG8_SA(1, 1), a1 + hstep, voffA);
            PG8_WAIT_L(8); PG8_BAR; PG8_WAIT_L(0); PG8_MMA(0, 0, At, B0); PG8_BAR; PG8_SCHED;
            PG8_LDB(B1, 0, 1); PG8_STAGE(PG8_SB(0, 0), b2, voffB);
            PG8_BAR; PG8_WAIT_L(0); PG8_MMA(0, 1, At, B1); PG8_BAR;
            PG8_LDA(At, 0, 1); PG8_STAGE(PG8_SA(0, 0), a2, voffA);
            PG8_BAR; PG8_WAIT_L(0); PG8_MMA(1, 0, At, B0); PG8_BAR; PG8_SCHED;
            PG8_STAGE(PG8_SB(0, 1), b2 + hstep, voffB);
            PG8_WAIT_V(6); PG8_BAR; PG8_MMA(1, 1, At, B1); PG8_BAR;
            PG8_LDB(B0, 1, 0); PG8_SCHED; PG8_LDA(At, 1, 0); PG8_STAGE(PG8_SA(0, 1), a2 + hstep, voffA);
            PG8_WAIT_L(8); PG8_BAR; PG8_WAIT_L(0); PG8_MMA(0, 0, At, B0); PG8_BAR; PG8_SCHED;
            PG8_LDB(B1, 1, 1); PG8_STAGE(PG8_SB(1, 0), b3, voffB);
            PG8_BAR; PG8_WAIT_L(0); PG8_MMA(0, 1, At, B1); PG8_BAR;
            PG8_LDA(At, 1, 1); PG8_STAGE(PG8_SA(1, 0), a3, voffA);
            PG8_BAR; PG8_WAIT_L(0); PG8_MMA(1, 0, At, B0); PG8_BAR; PG8_SCHED;
            PG8_STAGE(PG8_SB(1, 1), b3 + hstep, voffB);
            PG8_WAIT_V(6); PG8_BAR; PG8_MMA(1, 1, At, B1); PG8_BAR;
            }
        }
        if constexpr (ALIGN_EPI) { if (wr == 0) PG8_BAR; }
        if constexpr (F8) asm volatile("s_nop 15\n\ts_nop 15" ::: "memory");
        if constexpr (!Epi::AFTER_DRAIN) { E(acc, cur, wr, wc, fr, fq); S.done(cur); }
        if (!has_next) break;
        asm volatile("" : "+v"(zf_));
#pragma unroll
        for (int a = 0; a < 2; ++a)
#pragma unroll
            for (int b = 0; b < 2; ++b)
#pragma unroll
                for (int m = 0; m < 4; ++m)
#pragma unroll
                    for (int n = 0; n < 2; ++n) acc[a][b][m][n] = (f32x4){zf_, zf_, zf_, zf_};
        cur = nxt; cA = nA; cB = nB; ++ui;
        if constexpr (ALIGN_EPI) { if (wr == 1) PG8_BAR; }
    }
    PG8_WAIT_V(0);
    if constexpr (!ALIGN_EPI) { if (wr == 0) PG8_BAR; }
    PG8_BAR;
    if constexpr (Epi::AFTER_DRAIN) { E.fused(acc, cur, wr, wc, fr, fq, lds, wid, lane); S.done(cur); }
#undef PG8_SA
#undef PG8_SB
#undef PG8_STAGE
#undef PG8_LDA
#undef PG8_LDB
#undef PG8_MMA
#undef PG8_WAIT_V
#undef PG8_WAIT_L
#undef PG8_BAR
#undef PG8_SCHED
}
}


#ifndef CFG_D_MODEL
#define CFG_D_MODEL 4096
#define CFG_SEQ 4096
#define CFG_S5_STATE 64
#define CFG_MOBA_BLOCK 256
#define CFG_PEER_NKEYS 128
#define CFG_PEER_DKEY 256
#define CFG_PEER_TOPK 16
#endif
constexpr int D = CFG_D_MODEL, NB = 2, S = CFG_SEQ, T = NB * S, NL = 2;
constexpr int GW = D / 4;
constexpr int LRU_NBLK = 8, LRU_BLK = GW / LRU_NBLK;
constexpr int GLA_H = 4, GLA_DV = GW / GLA_H, GLA_DK = GLA_DV / 2, GLA_R = 16, GLA_HK = GLA_H * GLA_DK;
constexpr int S5_HG = 16, S5_G = GW / S5_HG, S5_P = CFG_S5_STATE, S5_GP = S5_G * S5_P;
constexpr int MB_H = 8, MB_HD = GW / MB_H, MB_BLK = CFG_MOBA_BLOCK, MB_NB = S / MB_BLK, MB_ROPE = MB_HD / 4, MB_SLOTS = 4 * MB_BLK;
constexpr int PE_H = 8, PE_NK = CFG_PEER_NKEYS, PE_E = PE_NK * PE_NK, PE_DK = CFG_PEER_DKEY, PE_DH = PE_DK / 2, PE_K = CFG_PEER_TOPK, PE_HK = PE_H * PE_K, PE_QW = PE_H * PE_DK;
constexpr int C_LRUX = 0, C_LRUG = GW, C_GQ = 2 * GW, C_GK = C_GQ + GLA_HK, C_GV = C_GK + GLA_HK, C_GLR = C_GV + GW, C_GOG = C_GLR + GLA_R,
              C_S5U = C_GOG + GW, C_MQ = C_S5U + GW, C_MK = C_MQ + GW, C_MV = C_MK + GW, INW = C_MV + GW, PLD = ((INW + 255) / 256) * 256;
constexpr float RMS_EPS = 1e-6f;
typedef unsigned short bf16_t;
#define LAS __attribute__((address_space(3)))
DEVFN int tid_fresh() { int t = threadIdx.x; asm volatile("" : "+v"(t)); return t; }
DEVFN int bid_fresh() { int b = blockIdx.x; asm volatile("" : "+s"(b)); return b; }
typedef unsigned u32x4v __attribute__((ext_vector_type(4)));
typedef float f32x4z_ __attribute__((ext_vector_type(4)));
DEVFN f32x4z_ zero4() { float z = 0.f; asm volatile("" : "+v"(z)); return (f32x4z_){z, z, z, z}; }
DEVFN u32x4v zero4u() { unsigned z = 0u; asm volatile("" : "+v"(z)); return (u32x4v){z, z, z, z}; }
DEVFN unsigned dpp_rowmax_u(unsigned v) {
    v = max(v, (unsigned)__builtin_amdgcn_update_dpp(0, (int)v, 0xB1, 0xF, 0xF, false));
    v = max(v, (unsigned)__builtin_amdgcn_update_dpp(0, (int)v, 0x4E, 0xF, 0xF, false));
    v = max(v, (unsigned)__builtin_amdgcn_update_dpp(0, (int)v, 0x141, 0xF, 0xF, false));
    v = max(v, (unsigned)__builtin_amdgcn_update_dpp(0, (int)v, 0x140, 0xF, 0xF, false));
    return v;
}
DEVFN float dpp_rowmax_f(float v) {
    v = fmaxf(v, __int_as_float(__builtin_amdgcn_update_dpp(0, __float_as_int(v), 0xB1, 0xF, 0xF, false)));
    v = fmaxf(v, __int_as_float(__builtin_amdgcn_update_dpp(0, __float_as_int(v), 0x4E, 0xF, 0xF, false)));
    v = fmaxf(v, __int_as_float(__builtin_amdgcn_update_dpp(0, __float_as_int(v), 0x141, 0xF, 0xF, false)));
    v = fmaxf(v, __int_as_float(__builtin_amdgcn_update_dpp(0, __float_as_int(v), 0x140, 0xF, 0xF, false)));
    return v;
}
DEVFN unsigned xrow16_max_u(unsigned v) { const auto r = __builtin_amdgcn_permlane16_swap(v, v, false, false); return max((unsigned)r[0], (unsigned)r[1]); }
DEVFN unsigned xrow32_max_u(unsigned v) { const auto r = __builtin_amdgcn_permlane32_swap(v, v, false, false); return max((unsigned)r[0], (unsigned)r[1]); }
DEVFN float xrow16_max_f(float v) { const auto r = __builtin_amdgcn_permlane16_swap(__float_as_uint(v), __float_as_uint(v), false, false); return fmaxf(__uint_as_float(r[0]), __uint_as_float(r[1])); }
DEVFN float xrow32_max_f(float v) { const auto r = __builtin_amdgcn_permlane32_swap(__float_as_uint(v), __float_as_uint(v), false, false); return fmaxf(__uint_as_float(r[0]), __uint_as_float(r[1])); }
DEVFN float dpp_rowsum_f(float v) {
    v += __int_as_float(__builtin_amdgcn_update_dpp(0, __float_as_int(v), 0xB1, 0xF, 0xF, false));
    v += __int_as_float(__builtin_amdgcn_update_dpp(0, __float_as_int(v), 0x4E, 0xF, 0xF, false));
    v += __int_as_float(__builtin_amdgcn_update_dpp(0, __float_as_int(v), 0x141, 0xF, 0xF, false));
    v += __int_as_float(__builtin_amdgcn_update_dpp(0, __float_as_int(v), 0x140, 0xF, 0xF, false));
    return v;
}
typedef unsigned u32x2v __attribute__((ext_vector_type(2)));
DEVFN bf16_t f2bf(float f) { unsigned u = __float_as_uint(f); u += 0x7FFFu + ((u >> 16) & 1u); return (bf16_t)(u >> 16); }
DEVFN float bf2f(bf16_t b) { return __uint_as_float(((unsigned)b) << 16); }
DEVFN unsigned pack2bf(float lo, float hi) { return (unsigned)f2bf(lo) | ((unsigned)f2bf(hi) << 16); }

struct WsLayout { size_t bar, sumsq, ssp, pli, plg, xbf, xq8, mixedb, pjb, gbc, gdec, gUT, gvT, gsp, galias_end, lA, lB, lxcb, lruW, s5bb, s5pw, s5el, s5kt, s5we, s5mc, s5zb, mkmean, midx, mqrb, mkrb, mvt, pqb, skb, P8, WinT, WoutT, WqT, GluT, U8, Vt8, end; };
constexpr WsLayout make_ws_layout() {
    WsLayout L{}; size_t o = 0;
#define WSF(name, bytes) L.name = o; o += (((size_t)(bytes)) + 255) & ~(size_t)255;
    WSF(bar, 3456 * 4 + 256) WSF(sumsq, (size_t)T * 4) WSF(ssp, (size_t)T * 64 * 4) WSF(pli, (size_t)T * PE_HK * 4) WSF(plg, (size_t)T * PE_HK * 4) WSF(xbf, (size_t)T * D * 2) WSF(xq8, (size_t)T * D) WSF(mixedb, (size_t)T * D * 2)
    WSF(pjb, (size_t)T * PLD * 2) WSF(gbc, (size_t)NB * GLA_H * (S / 64) * 64 * GLA_DK * 4) WSF(gdec, (size_t)NB * GLA_H * (S / 64) * GLA_DK * 4) WSF(gUT, (size_t)NB * GLA_H * (S / 64) * GLA_DV * GLA_DK * 4)
    WSF(gvT, (size_t)NB * GLA_H * (S / 64) * GLA_DV * 64 * 2) WSF(gsp, (size_t)NB * GLA_H * (S / 64) * GLA_DV * GLA_DK * 2) WSF(galias_end, 0)
    WSF(lA, (size_t)T * GW * 4) WSF(lB, (size_t)T * GW * 4) WSF(lxcb, (size_t)T * GW * 2) WSF(lruW, (size_t)2 * GW * GW * 2)
    WSF(s5bb, (size_t)S5_GP * S5_HG * 2 * 4) WSF(s5pw, (size_t)S5_GP * 65 * 2 * 4) WSF(s5el, (size_t)NB * S5_G * (S / 64) * 2 * S5_P * 4)
    WSF(s5kt, (size_t)S5_G * 64 * 256 * 2) WSF(s5we, (size_t)S5_G * 2 * S5_P * 64 * S5_HG * 2) WSF(s5mc, (size_t)S5_G * 64 * S5_HG * 2 * S5_P * 2) WSF(s5zb, (size_t)T * GW * 2)
    WSF(mkmean, (size_t)NB * MB_H * MB_NB * MB_HD * 4) WSF(midx, (size_t)NB * MB_H * S * 4) WSF(mqrb, (size_t)T * GW * 2) WSF(mkrb, (size_t)T * GW * 2) WSF(mvt, (size_t)T * GW * 2)
    WSF(pqb, (size_t)T * PE_QW * 2) WSF(skb, (size_t)PE_H * 2 * PE_NK * PE_DH * 2) WSF(P8, (size_t)T * PE_E)
    WSF(WinT, (size_t)PLD * D * 2) WSF(WoutT, (size_t)D * D * 2) WSF(WqT, (size_t)PE_QW * D * 2) WSF(GluT, (size_t)GW * GW * 2) WSF(U8, (size_t)PE_E * D) WSF(Vt8, (size_t)PE_E * D)
#undef WSF
    L.end = o; return L;
}
constexpr WsLayout WSL = make_ws_layout();
static_assert(WSL.galias_end - WSL.pjb >= (size_t)T * PE_E * 2, "the dense gate matrix must fit the region it aliases");
struct P {
    const float *x, *norm1_g, *w_in, *lru_conv_w, *lru_conv_b, *lru_wa, *lru_ba, *lru_wx, *lru_bx, *lru_lambda;
    const float *gla_wg2, *gla_bg, *gla_norm_g, *s5_a_re, *s5_a_im, *s5_log_step, *s5_b_re, *s5_b_im, *s5_c_re, *s5_c_im;
    const float *s5_d, *s5_w_glu, *s5_b_glu, *w_out, *norm2_g, *peer_wq, *peer_subkeys, *peer_u, *peer_v, *final_norm_g;
    float* out; unsigned char* ws;
#define WSA(type, name) __device__ __forceinline__ type* name() const { return (type*)(ws + WSL.name); }
    WSA(unsigned, bar) WSA(float, sumsq) WSA(float, ssp) WSA(int, pli) WSA(float, plg) WSA(bf16_t, xbf) WSA(unsigned char, xq8) WSA(bf16_t, mixedb)
    WSA(bf16_t, pjb) WSA(float, gbc) WSA(float, gdec) WSA(float, gUT) WSA(bf16_t, gvT) WSA(bf16_t, gsp)
    WSA(float, lA) WSA(float, lB) WSA(bf16_t, lxcb) WSA(bf16_t, lruW)
    WSA(float, s5bb) WSA(float, s5pw) WSA(float, s5el) WSA(bf16_t, s5kt) WSA(bf16_t, s5we) WSA(bf16_t, s5mc) WSA(bf16_t, s5zb)
    WSA(float, mkmean) WSA(int, midx) WSA(bf16_t, mqrb) WSA(bf16_t, mkrb) WSA(bf16_t, mvt)
    WSA(bf16_t, pqb) WSA(bf16_t, skb) WSA(unsigned char, P8)
    WSA(bf16_t, WinT) WSA(bf16_t, WoutT) WSA(bf16_t, WqT) WSA(bf16_t, GluT) WSA(unsigned char, U8) WSA(unsigned char, Vt8)
#undef WSA
    __device__ __forceinline__ bf16_t* A16() const { return (bf16_t*)(ws + WSL.pjb); }
};

DEVFN float fexp(float x) { return __builtin_amdgcn_exp2f(x * 1.4426950408889634f); }
DEVFN float sigmoidf_(float x) { return __builtin_amdgcn_rcpf(1.0f + fexp(-x)); }
DEVFN float softplusf_(float x) { return fmaxf(x, 0.0f) + 0.6931471805599453f * __builtin_amdgcn_logf(1.0f + fexp(-fabsf(x))); }
DEVFN float gelu_tanhf_(float x) { const float u = 0.7978845608028654f * (x + 0.044715f * x * x * x); return x * __builtin_amdgcn_rcpf(1.0f + fexp(-2.0f * u)); }
DEVFN float gelu_tanh_precise_(float x) { return 0.5f * x * (1.0f + tanhf(0.7978845608028654f * (x + 0.044715f * x * x * x))); }
DEVFN float gelu_erff_(float x) { return 0.5f * x * (1.0f + erff(x * 0.7071067811865476f)); }

typedef short bf16x8 __attribute__((ext_vector_type(8)));
typedef float f32x4 __attribute__((ext_vector_type(4)));
DEVFN unsigned pk2(float lo, float hi) { typedef float f2_ __attribute__((ext_vector_type(2))); typedef __bf16 b2_ __attribute__((ext_vector_type(2))); f2_ v = {lo, hi}; return __builtin_bit_cast(unsigned, __builtin_convertvector(v, b2_)); }
DEVFN float clamp8(float v) { return __builtin_amdgcn_fmed3f(v, -448.0f, 448.0f); }
DEVFN unsigned pk4f8(float a, float b, float c, float d) { int w = 0; w = __builtin_amdgcn_cvt_pk_fp8_f32(clamp8(a), clamp8(b), w, false); w = __builtin_amdgcn_cvt_pk_fp8_f32(clamp8(c), clamp8(d), w, true); return (unsigned)w; }
constexpr float F8S_X = 16.f, F8S_U = 1024.f, F8S_P = 32.f, F8S_V = 32.f, F8S_M = 16.f, F8S_W = 1024.f;
constexpr int MBP_PITCH = 272;

DEVFN void ph_mb_prep(const P& p, LAS unsigned char* lds) {
    const int tid = tid_fresh(), row = tid >> 1, half = tid & 1;
    LAS float* part = (LAS float*)(lds + 256 * MBP_PITCH);
    for (int u = bid_fresh(); u < NB * MB_NB * MB_H; u += gridDim.x) {
        const int b = u / (MB_NB * MB_H), j = (u / MB_H) % MB_NB, h = u % MB_H;
        const int pos = j * MB_BLK + row; const size_t t = (size_t)b * S + pos;
        const int c0 = h * MB_HD + half * 64;
#pragma unroll
        for (int which = 0; which < 3; ++which) {
            const bf16_t* src = p.pjb() + t * PLD + (which == 0 ? C_MQ : (which == 1 ? C_MK : C_MV)) + c0;
#pragma unroll
            for (int c = 0; c < 2; ++c) {
                float v[32];
#pragma unroll
                for (int i = 0; i < 4; ++i) { const uint4 x = *(const uint4*)(src + c * 32 + i * 8); const unsigned xw[4] = {x.x, x.y, x.z, x.w};
#pragma unroll
                    for (int j = 0; j < 4; ++j) { v[8 * i + 2 * j] = __uint_as_float(xw[j] << 16); v[8 * i + 2 * j + 1] = __uint_as_float(xw[j] & 0xffff0000u); } }
                if (which < 2 && half == 0 && c == 0) {
#pragma unroll
                    for (int i = 0; i < 16; ++i) {
                        const float inv = powf(500000.0f, -(float)i / 16.0f);
                        const float ang = (float)pos * inv; const float cs = cosf(ang), sn = sinf(ang);
                        const float a = v[i], bb = v[i + 16];
                        v[i] = a * cs - bb * sn; v[i + 16] = bb * cs + a * sn;
                    }
                }
                unsigned w[16];
#pragma unroll
                for (int i = 0; i < 16; ++i) w[i] = pk2(v[2 * i], v[2 * i + 1]);
                if (which < 2) {
                    bf16_t* dst = (which == 0 ? p.mqrb() : p.mkrb()) + t * GW + c0 + c * 32;
#pragma unroll
                    for (int i = 0; i < 4; ++i) *(uint4*)(dst + i * 8) = make_uint4(w[4 * i], w[4 * i + 1], w[4 * i + 2], w[4 * i + 3]);
                }
                if (which >= 1) {
                    LAS unsigned char* d2 = lds + row * MBP_PITCH + (half * 64 + c * 32) * 2;
#pragma unroll
                    for (int i = 0; i < 4; ++i) *(LAS u32x4v*)(d2 + i * 16) = (u32x4v){w[4 * i], w[4 * i + 1], w[4 * i + 2], w[4 * i + 3]};
                }
            }
            if (which == 1) {
                __syncthreads();
                { const int d = tid & 127, pt = tid >> 7; float s = 0.f;
                  for (int r = 0; r < 64; ++r) s += bf2f(*(const LAS bf16_t*)(lds + (pt * 64 + r) * MBP_PITCH + d * 2));
                  part[pt * 128 + d] = s; }
                __syncthreads();
                if (tid < 128) p.mkmean()[(((size_t)b * MB_H + h) * MB_NB + j) * MB_HD + tid] = (part[tid] + part[128 + tid] + part[256 + tid] + part[384 + tid]) * (1.0f / (float)MB_BLK);
                __syncthreads();
            }
            if (which == 2) {
                __syncthreads();
                { const int d = tid & 127, seg = tid >> 7;
                  bf16_t* dst = p.mvt() + (((size_t)b * MB_H + h) * MB_HD + d) * S + j * MB_BLK + seg * 64;
#pragma unroll
                  for (int g = 0; g < 8; ++g) {
                      unsigned w[4];
#pragma unroll
                      for (int i = 0; i < 4; ++i) {
                          const unsigned lo = *(const LAS bf16_t*)(lds + (seg * 64 + g * 8 + 2 * i) * MBP_PITCH + d * 2), hi = *(const LAS bf16_t*)(lds + (seg * 64 + g * 8 + 2 * i + 1) * MBP_PITCH + d * 2);
                          w[i] = lo | (hi << 16);
                      }
                      *(uint4*)(dst + g * 8) = make_uint4(w[0], w[1], w[2], w[3]);
                  } }
                __syncthreads();
            }
        }
    }
}

#define MBS_INS(g_, j_) do { if (i0 < 0 || (g_) > v0) { v2 = v1; i2 = i1; v1 = v0; i1 = i0; v0 = (g_); i0 = (j_); } else if (i1 < 0 || (g_) > v1) { v2 = v1; i2 = i1; v1 = (g_); i1 = (j_); } else if (i2 < 0 || (g_) > v2) { v2 = (g_); i2 = (j_); } } while (0)
DEVFN void mb_sel_job(const P& p, const int b, const int h, const int sg, const int lo, const int hi, LAS float* xv, LAS int* xi, const int slot, const int lane) {
    float v0 = -INFINITY, v1 = -INFINITY, v2 = -INFINITY; int i0 = -1, i1 = -1, i2 = -1;
    if (lo < hi) {
        const bf16_t* qp = p.mqrb() + ((size_t)b * S + sg * 64 + lane) * GW + h * MB_HD;
        float qf[MB_HD];
#pragma unroll
        for (int i = 0; i < MB_HD / 8; ++i) { const uint4 x = *(const uint4*)(qp + i * 8); const unsigned xw[4] = {x.x, x.y, x.z, x.w};
#pragma unroll
            for (int k = 0; k < 4; ++k) { qf[8 * i + 2 * k] = __uint_as_float(xw[k] << 16); qf[8 * i + 2 * k + 1] = __uint_as_float(xw[k] & 0xffff0000u); } }
        for (int j = lo; j < hi; ++j) {
            const float* km = p.mkmean() + (((size_t)b * MB_H + h) * MB_NB + j) * MB_HD;
            float g = 0.f;
#pragma unroll
            for (int d = 0; d < MB_HD; ++d) g += qf[d] * km[d];
            MBS_INS(g, j);
        }
    }
    xv[(slot * 3 + 0) * 64 + lane] = v0; xv[(slot * 3 + 1) * 64 + lane] = v1; xv[(slot * 3 + 2) * 64 + lane] = v2;
    xi[(slot * 3 + 0) * 64 + lane] = i0; xi[(slot * 3 + 1) * 64 + lane] = i1; xi[(slot * 3 + 2) * 64 + lane] = i2;
}
DEVFN void ph_mb_sel(const P& p, LAS unsigned char* lds) {
    static_assert(S / 64 == 64 && NB * MB_H == 16, "task pairing of the block selection");
    const int tid = tid_fresh(), lane = tid & 63, w = __builtin_amdgcn_readfirstlane(tid >> 6), q = w & 3, grp = w >> 2;
    LAS float* xv = (LAS float*)lds; LAS int* xi = (LAS int*)(lds + 16 * 3 * 64 * 4);
    __syncthreads();
    for (int wu = bid_fresh(); wu < 256; wu += gridDim.x) {
        const int s0 = wu & 31, bh = 2 * (wu >> 5) + grp, b = bh / MB_H, h = bh % MB_H;
#pragma unroll
        for (int ab = 0; ab < 2; ++ab) {
            const int sg = ab ? 63 - s0 : s0, own = (sg * 64) / MB_BLK;
            mb_sel_job(p, b, h, sg, (q * own) >> 2, ((q + 1) * own) >> 2, xv, xi, (grp * 2 + ab) * 4 + q, lane);
        }
        __syncthreads();
        if (q < 2) {
            const int ab = q, sg = ab ? 63 - s0 : s0;
            float v0 = -INFINITY, v1 = -INFINITY, v2 = -INFINITY; int i0 = -1, i1 = -1, i2 = -1;
#pragma unroll
            for (int r = 0; r < 4; ++r)
#pragma unroll
                for (int c = 0; c < 3; ++c) { const int slot = (grp * 2 + ab) * 4 + r; const float g = xv[(slot * 3 + c) * 64 + lane]; const int j = xi[(slot * 3 + c) * 64 + lane]; if (j >= 0) MBS_INS(g, j); }
            p.midx()[((size_t)b * MB_H + h) * S + sg * 64 + lane] = (i0 >= 0 ? (1 << i0) : 0) | (i1 >= 0 ? (1 << i1) : 0) | (i2 >= 0 ? (1 << i2) : 0);
        }
        __syncthreads();
    }
}

constexpr int MBA_KP = 272, MBA_VP = 144;
constexpr int MBA_KB = 64 * MBA_KP, MBA_VB = 128 * MBA_VP, MBA_BUF = MBA_KB + MBA_VB;
template <int NQT> DEVFN void mb_attn_unit(const P& p, LAS unsigned char* lds, const int b, const int h, const int i, const int qoff) {
    const int tid = tid_fresh(), w = __builtin_amdgcn_readfirstlane(tid >> 6), lane = tid & 63, l15 = lane & 15, quad = lane >> 4;
    const int q0 = i * MB_BLK + qoff + 16 * NQT * w;
    bf16x8 qf[NQT][4]; int msk[NQT], qpos[NQT];
#pragma unroll
    for (int qt = 0; qt < NQT; ++qt) {
        qpos[qt] = q0 + 16 * qt + l15;
        const bf16_t* qp = p.mqrb() + ((size_t)b * S + qpos[qt]) * GW + h * MB_HD + quad * 8;
#pragma unroll
        for (int ks = 0; ks < 4; ++ks) qf[qt][ks] = *(const bf16x8*)(qp + 32 * ks);
        msk[qt] = p.midx()[((size_t)b * MB_H + h) * S + qpos[qt]];
    }
    f32x4 o[8][NQT]; float mrow[NQT], lsum[NQT];
#pragma unroll
    for (int qt = 0; qt < NQT; ++qt) { mrow[qt] = -INFINITY; lsum[qt] = 0.f;
#pragma unroll
        for (int dt = 0; dt < 8; ++dt) o[dt][qt] = zero4(); }
    const float sc2 = 1.4426950408889634f / sqrtf((float)MB_HD);
    const bf16_t* kbase = p.mkrb() + (size_t)b * S * GW + h * MB_HD;
    const bf16_t* vbase = p.mvt() + ((size_t)b * MB_H + h) * MB_HD * S;
    const int ntile = (i + 1) * 4;
    const int kc0 = tid, kc1 = tid + 512;
    const int vc0 = tid, vc1 = tid + 512;
    u32x4v rk0, rk1, rv0, rv1;
#define MBA_LOAD(tau) do { const int _jj = (tau) >> 2, _j = (_jj == 0) ? i : _jj - 1, _key0 = _j * MB_BLK + ((tau) & 3) * 64; \
        rk0 = *(const u32x4v*)(kbase + (size_t)(_key0 + (kc0 >> 4)) * GW + (kc0 & 15) * 8); rk1 = *(const u32x4v*)(kbase + (size_t)(_key0 + (kc1 >> 4)) * GW + (kc1 & 15) * 8); \
        rv0 = *(const u32x4v*)(vbase + (size_t)(vc0 >> 3) * S + _key0 + (vc0 & 7) * 8); rv1 = *(const u32x4v*)(vbase + (size_t)(vc1 >> 3) * S + _key0 + (vc1 & 7) * 8); } while (0)
#define MBA_STORE(buf) do { LAS unsigned char* _kb = lds + (buf) * MBA_BUF; LAS unsigned char* _vb = _kb + MBA_KB; \
        *(LAS u32x4v*)(_kb + (kc0 >> 4) * MBA_KP + (kc0 & 15) * 16) = rk0; *(LAS u32x4v*)(_kb + (kc1 >> 4) * MBA_KP + (kc1 & 15) * 16) = rk1; \
        *(LAS u32x4v*)(_vb + (vc0 >> 3) * MBA_VP + (vc0 & 7) * 16) = rv0; *(LAS u32x4v*)(_vb + (vc1 >> 3) * MBA_VP + (vc1 & 7) * 16) = rv1; } while (0)
    MBA_LOAD(0); MBA_STORE(0);
    __syncthreads();
    for (int tau = 0; tau < ntile; ++tau) {
        if (tau + 1 < ntile) MBA_LOAD(tau + 1);
        const int jj = tau >> 2, j = (jj == 0) ? i : jj - 1, key0 = j * MB_BLK + (tau & 3) * 64; const bool own = (jj == 0);
        const LAS unsigned char* kb = lds + (tau & 1) * MBA_BUF; const LAS unsigned char* vb = kb + MBA_KB;
        f32x4 s[4][NQT];
#pragma unroll
        for (int kt = 0; kt < 4; ++kt) {
#pragma unroll
            for (int qt = 0; qt < NQT; ++qt) s[kt][qt] = zero4();
#pragma unroll
            for (int ks = 0; ks < 4; ++ks) {
                const bf16x8 kf = *(const LAS bf16x8*)(kb + (16 * kt + l15) * MBA_KP + 64 * ks + quad * 16);
#pragma unroll
                for (int qt = 0; qt < NQT; ++qt) s[kt][qt] = __builtin_amdgcn_mfma_f32_16x16x32_bf16(kf, qf[qt][ks], s[kt][qt], 0, 0, 0);
            }
        }
        bf16x8 pf[NQT][2];
#pragma unroll
        for (int qt = 0; qt < NQT; ++qt) {
            float tmax = -INFINITY;
            if (own) {
#pragma unroll
                for (int kt = 0; kt < 4; ++kt)
#pragma unroll
                    for (int e = 0; e < 4; ++e) {
                        const int key = key0 + 16 * kt + quad * 4 + e;
                        const float v = (key <= qpos[qt]) ? s[kt][qt][e] * sc2 : -INFINITY;
                        s[kt][qt][e] = v; tmax = fmaxf(tmax, v);
                    }
            } else {
                const float bias = ((msk[qt] >> j) & 1) ? 0.0f : -INFINITY;
#pragma unroll
                for (int kt = 0; kt < 4; ++kt)
#pragma unroll
                    for (int e = 0; e < 4; ++e) { const float v = __builtin_fmaf(s[kt][qt][e], sc2, bias); s[kt][qt][e] = v; tmax = fmaxf(tmax, v); }
            }
            tmax = xrow32_max_f(xrow16_max_f(tmax));
            const float mnew = fmaxf(mrow[qt], tmax);
            const float alpha = __builtin_amdgcn_exp2f(mrow[qt] - mnew);
            mrow[qt] = mnew;
            float ps = 0.f;
#pragma unroll
            for (int kt = 0; kt < 4; ++kt)
#pragma unroll
                for (int e = 0; e < 4; ++e) { const float pv = __builtin_amdgcn_exp2f(s[kt][qt][e] - mnew); s[kt][qt][e] = pv; ps += pv; }
            lsum[qt] = lsum[qt] * alpha + ps;
            if (__builtin_amdgcn_ballot_w64(alpha != 1.0f) != 0ull) {
#pragma unroll
                for (int dt = 0; dt < 8; ++dt) o[dt][qt] *= alpha;
            }
#pragma unroll
            for (int k2 = 0; k2 < 2; ++k2) {
                typedef unsigned u32x4_ __attribute__((ext_vector_type(4)));
                u32x4_ pw; pw.x = pk2(s[2 * k2][qt][0], s[2 * k2][qt][1]); pw.y = pk2(s[2 * k2][qt][2], s[2 * k2][qt][3]);
                pw.z = pk2(s[2 * k2 + 1][qt][0], s[2 * k2 + 1][qt][1]); pw.w = pk2(s[2 * k2 + 1][qt][2], s[2 * k2 + 1][qt][3]);
                pf[qt][k2] = __builtin_bit_cast(bf16x8, pw);
            }
        }
#pragma unroll
        for (int k2 = 0; k2 < 2; ++k2)
#pragma unroll
            for (int dt = 0; dt < 8; ++dt) {
                typedef unsigned u32x2_ __attribute__((ext_vector_type(2))); typedef unsigned u32x4_ __attribute__((ext_vector_type(4)));
                const LAS unsigned char* vp = vb + (16 * dt + l15) * MBA_VP + (32 * k2 + quad * 4) * 2;
                const u32x2_ lo = *(const LAS u32x2_*)vp, hi = *(const LAS u32x2_*)(vp + 32);
                u32x4_ vw; vw.x = lo.x; vw.y = lo.y; vw.z = hi.x; vw.w = hi.y;
                const bf16x8 vf = __builtin_bit_cast(bf16x8, vw);
#pragma unroll
                for (int qt = 0; qt < NQT; ++qt) o[dt][qt] = __builtin_amdgcn_mfma_f32_16x16x32_bf16(vf, pf[qt][k2], o[dt][qt], 0, 0, 0);
            }
        if (tau + 1 < ntile) MBA_STORE((tau + 1) & 1);
        __syncthreads();
    }
#undef MBA_LOAD
#undef MBA_STORE
#pragma unroll
    for (int qt = 0; qt < NQT; ++qt) {
        float lt = lsum[qt]; lt += __shfl_xor(lt, 16); lt += __shfl_xor(lt, 32);
        const float inv = 1.0f / lt;
        unsigned char* dst = (unsigned char*)p.mixedb() + ((size_t)b * S + qpos[qt]) * D + 3 * GW + h * MB_HD + quad * 4;
#pragma unroll
        for (int dt = 0; dt < 8; ++dt) { const f32x4 v = o[dt][qt] * (inv * F8S_M); *(unsigned*)(dst + 16 * dt) = pk4f8(v[0], v[1], v[2], v[3]); }
    }
}
DEVFN void mb_attn_pair(const P& p, LAS unsigned char* lds, const int r) {
    const int i = MB_NB - 1 - r / (NB * MB_H), bh = r % (NB * MB_H), b = bh / MB_H, h = bh % MB_H;
    mb_attn_unit<2>(p, lds, b, h, i, 0);
}
constexpr int MB_PAIRS = NB * MB_H * MB_NB;

DEVFN void b_cvt8(const float* __restrict__ src, unsigned char* __restrict__ dst, const float* __restrict__ g, int K, float scale, long gid) {
    const size_t i = (size_t)gid * 8; const int k = (int)(i % K);
    const float4 a = *(const float4*)(src + i), b = *(const float4*)(src + i + 4);
    const float4 ga = *(const float4*)(g + k), gb = *(const float4*)(g + k + 4);
    *(uint2*)(dst + i) = make_uint2(pk4f8(a.x * ga.x * scale, a.y * ga.y * scale, a.z * ga.z * scale, a.w * ga.w * scale), pk4f8(b.x * gb.x * scale, b.y * gb.y * scale, b.z * gb.z * scale, b.w * gb.w * scale));
}
DEVFN void ph_cvt8_stream(const float* __restrict__ src, unsigned char* __restrict__ dst, const float* __restrict__ g, const int K, const float scale, const long n8) {
    const int tid = tid_fresh(); const long stride = (long)gridDim.x * 512;
    for (long base = (long)bid_fresh() * 512 + tid; base < n8; base += 4 * stride) {
        float4 a[4], b[4];
#pragma unroll
        for (int j = 0; j < 4; ++j) { const long gid = base + j * stride; if (gid < n8) { a[j] = *(const float4*)(src + gid * 8); b[j] = *(const float4*)(src + gid * 8 + 4); } }
#pragma unroll
        for (int j = 0; j < 4; ++j) { const long gid = base + j * stride; if (gid < n8) {
            const int k = (int)((gid * 8) % K); const float4 ga = *(const float4*)(g + k), gb = *(const float4*)(g + k + 4);
            *(uint2*)(dst + gid * 8) = make_uint2(pk4f8(a[j].x * ga.x * scale, a[j].y * ga.y * scale, a[j].z * ga.z * scale, a[j].w * ga.w * scale), pk4f8(b[j].x * gb.x * scale, b[j].y * gb.y * scale, b[j].z * gb.z * scale, b[j].w * gb.w * scale)); } }
    }
}
struct EpiF32S {
    static constexpr bool PERM = false, AFTER_DRAIN = false;
    float* C; const float* sumsq; const float* R; int ldc; int ldr;
    __device__ __forceinline__ void operator()(const pg8::f32x4 (&acc)[2][2][4][2], const pg8::Unit& u, int wr, int wc, int fr, int fq) const {
        const int row0 = u.pm * 256 + wr * 64 + fr, col0 = u.pn * 256 + wc * 32 + 4 * fq;
#pragma unroll
        for (int ai = 0; ai < 2; ++ai)
#pragma unroll
            for (int m = 0; m < 4; ++m) {
                const int row = row0 + ai * 128 + m * 16;
                const float sc = sumsq ? 1.0f / sqrtf(sumsq[row] * (1.0f / (float)D) + RMS_EPS) : 1.0f;
#pragma unroll
                for (int bj = 0; bj < 2; ++bj)
#pragma unroll
                    for (int n = 0; n < 2; ++n) {
                        const int col = col0 + bj * 128 + n * 16;
                        pg8::f32x4 v = acc[ai][bj][m][n] * sc;
                        if (R) v += *(const pg8::f32x4*)(R + (size_t)row * ldr + col);
                        *(pg8::f32x4*)(C + (size_t)row * ldc + col) = v;
                    }
            }
    }
};
template <int MI, int NI, int KS> DEVFN void wave_mma(const LAS unsigned char* A, const int pa, const LAS unsigned char* B, const int pb, f32x4 (&acc)[MI][NI], const int l15, const int quad) {
#pragma unroll
    for (int ks = 0; ks < KS; ++ks) {
        bf16x8 af[MI], bfr[NI];
#pragma unroll
        for (int mi = 0; mi < MI; ++mi) af[mi] = *(const LAS bf16x8*)(A + (16 * mi + l15) * pa + 64 * ks + quad * 16);
#pragma unroll
        for (int ni = 0; ni < NI; ++ni) bfr[ni] = *(const LAS bf16x8*)(B + (16 * ni + l15) * pb + 64 * ks + quad * 16);
#pragma unroll
        for (int mi = 0; mi < MI; ++mi)
#pragma unroll
            for (int ni = 0; ni < NI; ++ni) acc[mi][ni] = __builtin_amdgcn_mfma_f32_16x16x32_bf16(af[mi], bfr[ni], acc[mi][ni], 0, 0, 0);
    }
}
template <int MI, int NI, int KS> DEVFN void wave_mma_gb(const LAS unsigned char* A, const int pa, const bf16_t* __restrict__ B, const int ldb, f32x4 (&acc)[MI][NI], const int l15, const int quad) {
#pragma unroll
    for (int ks = 0; ks < KS; ++ks) {
        bf16x8 af[MI], bfr[NI];
#pragma unroll
        for (int ni = 0; ni < NI; ++ni) bfr[ni] = *(const bf16x8*)(B + (size_t)(16 * ni + l15) * ldb + 32 * ks + quad * 8);
#pragma unroll
        for (int mi = 0; mi < MI; ++mi) af[mi] = *(const LAS bf16x8*)(A + (16 * mi + l15) * pa + 64 * ks + quad * 16);
#pragma unroll
        for (int mi = 0; mi < MI; ++mi)
#pragma unroll
            for (int ni = 0; ni < NI; ++ni) acc[mi][ni] = __builtin_amdgcn_mfma_f32_16x16x32_bf16(af[mi], bfr[ni], acc[mi][ni], 0, 0, 0);
    }
}
DEVFN void ld16bf(const bf16_t* __restrict__ src, float (&v)[16]) {
    const uint4 a = *(const uint4*)src, b = *(const uint4*)(src + 8);
    const unsigned w[8] = {a.x, a.y, a.z, a.w, b.x, b.y, b.z, b.w};
#pragma unroll
    for (int i = 0; i < 8; ++i) { v[2 * i] = __uint_as_float(w[i] << 16); v[2 * i + 1] = __uint_as_float(w[i] & 0xffff0000u); }
}
constexpr int GLA_C = 64, GLA_NCH = S / GLA_C, GLA_UNITS = NB * GLA_H * GLA_NCH;
static_assert(GLA_DK == 128 && GLA_DV == 256 && GLA_R == 16, "GLA phases are written for dk 128, dv 256, gate rank 16");
DEVFN void ph_gla_s1(const P& p, const int l, LAS unsigned char* lds) {
    const int tid = tid_fresh(), w = __builtin_amdgcn_readfirstlane(tid >> 6), lane = tid & 63, l15 = lane & 15, quad = lane >> 4;
    LAS float* gbuf = (LAS float*)lds;
    LAS unsigned char* kdT = lds + 33280;
    LAS unsigned char* vT = lds + 33280 + 18432;
    for (int u = bid_fresh(); u < GLA_UNITS; u += gridDim.x) {
        const int b = u / (GLA_H * GLA_NCH), h = (u / GLA_NCH) % GLA_H, n = u % GLA_NCH;
        const size_t t0 = (size_t)b * S + (size_t)n * GLA_C;
        const int c = tid >> 3, seg = tid & 7;
        LAS float* wgs = (LAS float*)(lds + 88576);
        LAS float* ctot = wgs + 16 * 128;
        for (int i = tid; i < GLA_R * GLA_DK; i += 512) wgs[i] = p.gla_wg2[(size_t)l * GLA_R * GLA_HK + (size_t)(i >> 7) * GLA_HK + h * GLA_DK + (i & 127)];
        __syncthreads();
        {
            float gl[16]; ld16bf(p.pjb() + (t0 + c) * PLD + C_GLR, gl);
            const float* bg = p.gla_bg + (size_t)l * GLA_HK + h * GLA_DK + seg * 16;
            float a[16];
#pragma unroll
            for (int i = 0; i < 16; ++i) a[i] = bg[i];
#pragma unroll
            for (int r = 0; r < 16; ++r)
#pragma unroll
                for (int q4 = 0; q4 < 4; ++q4) { const f32x4 wv = *(const LAS f32x4*)(wgs + r * 128 + seg * 16 + q4 * 4);
#pragma unroll
                    for (int j = 0; j < 4; ++j) a[q4 * 4 + j] += gl[r] * wv[j]; }
#pragma unroll
            for (int i = 0; i < 16; ++i) gbuf[c * 129 + seg * 16 + i] = -softplusf_(-a[i]) * (1.0f / 16.0f);
        }
        {
            const bf16_t* vp = p.pjb() + (t0 + c) * PLD + C_GV + h * GLA_DV + seg * 32;
#pragma unroll
            for (int q4 = 0; q4 < 4; ++q4) {
                const uint4 x = *(const uint4*)(vp + q4 * 8); const unsigned wv[4] = {x.x, x.y, x.z, x.w};
#pragma unroll
                for (int i = 0; i < 4; ++i) {
                    *(LAS bf16_t*)(vT + (seg * 32 + q4 * 8 + 2 * i) * 144 + c * 2) = (bf16_t)(wv[i] & 0xffffu);
                    *(LAS bf16_t*)(vT + (seg * 32 + q4 * 8 + 2 * i + 1) * 144 + c * 2) = (bf16_t)(wv[i] >> 16);
                }
            }
        }
        __syncthreads();
        {
            const int d = tid & 127, qt = tid >> 7;
            float tsum = 0.f;
#pragma unroll
            for (int cc = 0; cc < 16; ++cc) tsum += gbuf[(qt * 16 + cc) * 129 + d];
            ctot[qt * 128 + d] = tsum;
            __syncthreads();
            float run = 0.f;
            for (int q2 = 0; q2 < qt; ++q2) run += ctot[q2 * 128 + d];
#pragma unroll
            for (int cc = 0; cc < 16; ++cc) { const int ci = qt * 16 + cc; run += gbuf[ci * 129 + d]; gbuf[ci * 129 + d] = run; p.gbc()[((size_t)u * GLA_C + ci) * GLA_DK + d] = run; }
            if (qt == 3) p.gdec()[(size_t)u * GLA_DK + d] = fexp(run);
            const int e = tid >> 1, hf = tid & 1;
            bf16_t* dst = p.gvT() + ((size_t)u * GLA_DV + e) * GLA_C + hf * 32;
#pragma unroll
            for (int i = 0; i < 4; ++i) *(u32x4v*)(dst + i * 8) = *(const LAS u32x4v*)(vT + e * 144 + hf * 64 + i * 16);
        }
        __syncthreads();
        {
            float kv[16]; ld16bf(p.pjb() + (t0 + c) * PLD + C_GK + h * GLA_DK + seg * 16, kv);
#pragma unroll
            for (int i = 0; i < 16; ++i) {
                const int d = seg * 16 + i;
                const float kd = kv[i] * fexp(gbuf[63 * 129 + d] - gbuf[c * 129 + d]);
                *(LAS bf16_t*)(kdT + d * 144 + c * 2) = (bf16_t)(pk2(kd, 0.f) & 0xffffu);
            }
        }
        __syncthreads();
        {
            f32x4 acc[2][8];
#pragma unroll
            for (int mi = 0; mi < 2; ++mi)
#pragma unroll
                for (int ni = 0; ni < 8; ++ni) acc[mi][ni] = zero4();
            wave_mma<2, 8, 2>(vT + 32 * w * 144, 144, kdT, 144, acc, l15, quad);
            float* U = p.gUT() + (size_t)u * GLA_DV * GLA_DK;
#pragma unroll
            for (int mi = 0; mi < 2; ++mi)
#pragma unroll
                for (int ni = 0; ni < 8; ++ni)
#pragma unroll
                    for (int j = 0; j < 4; ++j) U[(size_t)(32 * w + 16 * mi + quad * 4 + j) * GLA_DK + 16 * ni + l15] = acc[mi][ni][j];
        }
        __syncthreads();
    }
}
DEVFN void b_gla_s2(const P& p, const int l, long gid) {
    const int d = (int)(gid % GLA_DK); const int e = (int)((gid / GLA_DK) % GLA_DV); const int bh = (int)(gid / ((long)GLA_DK * GLA_DV));
    float st = 0.f;
    for (int n = 0; n < GLA_NCH; ++n) {
        const size_t u = (size_t)bh * GLA_NCH + n; const size_t o = (u * GLA_DV + e) * GLA_DK + d;
        p.gsp()[o] = (bf16_t)(pk2(st, 0.f) & 0xffffu);
        st = p.gdec()[u * GLA_DK + d] * st + p.gUT()[o];
    }
}
DEVFN void b_gla_s2x(const P& p, const int l, long gid) {
    const int d = (int)(gid % (GLA_DK / 2)) * 2; const int e = (int)((gid / (GLA_DK / 2)) % GLA_DV); const int bh = (int)(gid / ((long)(GLA_DK / 2) * GLA_DV));
    float s0 = 0.f, s1 = 0.f;
#pragma unroll 1
    for (int n0 = 0; n0 < GLA_NCH; n0 += 8) {
        float2 uv[8], dv[8];
#pragma unroll
        for (int j = 0; j < 8; ++j) { const size_t u = (size_t)bh * GLA_NCH + n0 + j; uv[j] = *(const float2*)(p.gUT() + (u * GLA_DV + e) * GLA_DK + d); dv[j] = *(const float2*)(p.gdec() + u * GLA_DK + d); }
#pragma unroll
        for (int j = 0; j < 8; ++j) { const size_t u = (size_t)bh * GLA_NCH + n0 + j;
            *(unsigned*)(p.gsp() + (u * GLA_DV + e) * GLA_DK + d) = pk2(s0, s1);
            s0 = dv[j].x * s0 + uv[j].x; s1 = dv[j].y * s1 + uv[j].y; }
    }
}
DEVFN void ph_gla_s3(const P& p, const int l, LAS unsigned char* lds, const int u0, const int uend, const int ustep) {
    const int tid = tid_fresh(), w = __builtin_amdgcn_readfirstlane(tid >> 6), lane = tid & 63, l15 = lane & 15, quad = lane >> 4;
    LAS unsigned char* qe = lds;
    LAS unsigned char* ke = lds + 17408;
    LAS unsigned char* att = lds + 34816;
    LAS float* rowsq = (LAS float*)(lds + 44032);
    LAS unsigned char* obuf = lds + 46080;
    for (int u = u0; u < uend; u += ustep) {
        const int b = u / (GLA_H * GLA_NCH), h = (u / GLA_NCH) % GLA_H, n = u % GLA_NCH;
        const size_t t0 = (size_t)b * S + (size_t)n * GLA_C;
        {
            const int c = tid >> 3, seg = tid & 7;
            float qv[16], kv[16];
            ld16bf(p.pjb() + (t0 + c) * PLD + C_GQ + h * GLA_DK + seg * 16, qv); ld16bf(p.pjb() + (t0 + c) * PLD + C_GK + h * GLA_DK + seg * 16, kv);
            const float* bc = p.gbc() + ((size_t)u * GLA_C + c) * GLA_DK + seg * 16;
            unsigned wq[8], wk[8];
#pragma unroll
            for (int i = 0; i < 8; ++i) {
                const float b0 = bc[2 * i], b1 = bc[2 * i + 1];
                const float e0 = fexp(b0), e1 = fexp(b1);
                wq[i] = pk2(qv[2 * i] * 0.08838834764831845f * e0, qv[2 * i + 1] * 0.08838834764831845f * e1);
                wk[i] = pk2(kv[2 * i] * __builtin_amdgcn_rcpf(e0), kv[2 * i + 1] * __builtin_amdgcn_rcpf(e1));
            }
            *(LAS u32x4v*)(qe + c * 272 + seg * 32) = (u32x4v){wq[0], wq[1], wq[2], wq[3]}; *(LAS u32x4v*)(qe + c * 272 + seg * 32 + 16) = (u32x4v){wq[4], wq[5], wq[6], wq[7]};
            *(LAS u32x4v*)(ke + c * 272 + seg * 32) = (u32x4v){wk[0], wk[1], wk[2], wk[3]}; *(LAS u32x4v*)(ke + c * 272 + seg * 32 + 16) = (u32x4v){wk[4], wk[5], wk[6], wk[7]};
        }
        __syncthreads();
        {
            const int mi0 = w >> 1, nb = (w & 1) * 2;
            f32x4 a2[1][2]; a2[0][0] = zero4(); a2[0][1] = a2[0][0];
            wave_mma<1, 2, 4>(qe + 16 * mi0 * 272, 272, ke + 16 * nb * 272, 272, a2, l15, quad);
#pragma unroll
            for (int ni = 0; ni < 2; ++ni)
#pragma unroll
                for (int j = 0; j < 4; ++j) {
                    const int cc = 16 * mi0 + quad * 4 + j, jt = 16 * (nb + ni) + l15;
                    *(LAS bf16_t*)(att + cc * 144 + jt * 2) = (bf16_t)(pk2(jt <= cc ? a2[0][ni][j] : 0.f, 0.f) & 0xffffu);
                }
        }
        __syncthreads();
        {
            f32x4 o[4][2];
#pragma unroll
            for (int mi = 0; mi < 4; ++mi) { o[mi][0] = zero4(); o[mi][1] = o[mi][0]; }
            wave_mma_gb<4, 2, 2>(att, 144, p.gvT() + ((size_t)u * GLA_DV + 32 * w) * GLA_C, GLA_C, o, l15, quad);
            wave_mma_gb<4, 2, 4>(qe, 272, p.gsp() + ((size_t)u * GLA_DV + 32 * w) * GLA_DK, GLA_DK, o, l15, quad);
#pragma unroll
            for (int mi = 0; mi < 4; ++mi)
#pragma unroll
                for (int j = 0; j < 4; ++j) {
                    float s2 = o[mi][0][j] * o[mi][0][j] + o[mi][1][j] * o[mi][1][j];
                    s2 += __shfl_xor(s2, 1); s2 += __shfl_xor(s2, 2); s2 += __shfl_xor(s2, 4); s2 += __shfl_xor(s2, 8);
                    if (l15 == 0) rowsq[w * 64 + 16 * mi + quad * 4 + j] = s2;
                }
            __syncthreads();
            const float* ng = p.gla_norm_g + (size_t)l * GW + h * GLA_DV + 32 * w;
#pragma unroll
            for (int mi = 0; mi < 4; ++mi)
#pragma unroll
                for (int j = 0; j < 4; ++j) {
                    const int cc = 16 * mi + quad * 4 + j;
                    float rq = 0.f;
#pragma unroll
                    for (int ww = 0; ww < 8; ++ww) rq += rowsq[ww * 64 + cc];
                    const float rs = 1.0f / sqrtf(rq * (1.0f / (float)GLA_DV) + RMS_EPS);
#pragma unroll
                    for (int ni = 0; ni < 2; ++ni) {
                        const int e = 16 * ni + l15;
                        *(LAS bf16_t*)(obuf + cc * 528 + (32 * w + e) * 2) = (bf16_t)(pk2(o[mi][ni][j] * rs * ng[e], 0.f) & 0xffffu);
                    }
                }
            __syncthreads();
            {
                const int c2 = tid >> 3, es = (tid & 7) * 32;
                const bf16_t* ogp = p.pjb() + (t0 + c2) * PLD + C_GOG + h * GLA_DV + es; unsigned char* dst = (unsigned char*)p.mixedb() + (t0 + c2) * D + GW + h * GLA_DV + es;
#pragma unroll
                for (int i = 0; i < 4; ++i) {
                    const uint4 gw = *(const uint4*)(ogp + i * 8); const u32x4v ow = *(const LAS u32x4v*)(obuf + c2 * 528 + (es + i * 8) * 2);
                    const unsigned g4[4] = {gw.x, gw.y, gw.z, gw.w}; const unsigned o4[4] = {ow.x, ow.y, ow.z, ow.w}; float r8[8];
#pragma unroll
                    for (int jj = 0; jj < 4; ++jj) { const float g0 = __uint_as_float(g4[jj] << 16), g1 = __uint_as_float(g4[jj] & 0xffff0000u);
                        r8[2 * jj] = __uint_as_float(o4[jj] << 16) * (g0 * sigmoidf_(g0)) * F8S_M; r8[2 * jj + 1] = __uint_as_float(o4[jj] & 0xffff0000u) * (g1 * sigmoidf_(g1)) * F8S_M; }
                    *(uint2*)(dst + i * 8) = make_uint2(pk4f8(r8[0], r8[1], r8[2], r8[3]), pk4f8(r8[4], r8[5], r8[6], r8[7]));
                }
            }
        }
        __syncthreads();
    }
}

DEVFN void b_lru_conv2(const P& p, const int l, long gid) {
    const long t = gid / (GW / 8); const int c = (int)(gid % (GW / 8)) * 8; const int s = (int)(t % S);
    const float* cw = p.lru_conv_w + (size_t)l * 4 * GW + c; const float* cb = p.lru_conv_b + (size_t)l * GW + c;
    float acc[8];
#pragma unroll
    for (int i = 0; i < 8; ++i) acc[i] = cb[i];
#pragma unroll
    for (int j = 0; j < 4; ++j) {
        if (s - 3 + j >= 0) {
            const uint4 x = *(const uint4*)(p.pjb() + (size_t)(t - 3 + j) * PLD + C_LRUX + c); const unsigned w[4] = {x.x, x.y, x.z, x.w};
#pragma unroll
            for (int i = 0; i < 4; ++i) { acc[2 * i] += cw[j * GW + 2 * i] * __uint_as_float(w[i] << 16); acc[2 * i + 1] += cw[j * GW + 2 * i + 1] * __uint_as_float(w[i] & 0xffff0000u); }
        }
    }
    *(uint4*)(p.lxcb() + (size_t)t * GW + c) = make_uint4(pk2(acc[0], acc[1]), pk2(acc[2], acc[3]), pk2(acc[4], acc[5]), pk2(acc[6], acc[7]));
}
DEVFN void b_lru_conv3(const P& p, const int l, long gid) {
    const long tg = gid / (GW / 8); const int c = (int)(gid % (GW / 8)) * 8; const long t = tg * 4; const int s = (int)(t % S);
    const float* cw = p.lru_conv_w + (size_t)l * 4 * GW + c; const float* cb = p.lru_conv_b + (size_t)l * GW + c;
    float w[4][8], x[7][8], bias[8];
#pragma unroll
    for (int j = 0; j < 4; ++j) { const float4 a = *(const float4*)(cw + j * GW), b = *(const float4*)(cw + j * GW + 4); w[j][0] = a.x; w[j][1] = a.y; w[j][2] = a.z; w[j][3] = a.w; w[j][4] = b.x; w[j][5] = b.y; w[j][6] = b.z; w[j][7] = b.w; }
    { const float4 a = *(const float4*)cb, b = *(const float4*)(cb + 4); bias[0] = a.x; bias[1] = a.y; bias[2] = a.z; bias[3] = a.w; bias[4] = b.x; bias[5] = b.y; bias[6] = b.z; bias[7] = b.w; }
#pragma unroll
    for (int r = 0; r < 7; ++r) {
        uint4 v = make_uint4(0u, 0u, 0u, 0u);
        if (s + r - 3 >= 0) v = *(const uint4*)(p.pjb() + (size_t)(t + r - 3) * PLD + C_LRUX + c);
        const unsigned vw[4] = {v.x, v.y, v.z, v.w};
#pragma unroll
        for (int i = 0; i < 4; ++i) { x[r][2 * i] = __uint_as_float(vw[i] << 16); x[r][2 * i + 1] = __uint_as_float(vw[i] & 0xffff0000u); }
    }
#pragma unroll
    for (int k = 0; k < 4; ++k) {
        float acc[8];
#pragma unroll
        for (int i = 0; i < 8; ++i) { acc[i] = bias[i];
#pragma unroll
            for (int j = 0; j < 4; ++j) acc[i] += w[j][i] * x[k + j][i]; }
        *(uint4*)(p.lxcb() + ((size_t)(c / LRU_BLK) * T + (size_t)(t + k)) * LRU_BLK + (c % LRU_BLK)) = make_uint4(pk2(acc[0], acc[1]), pk2(acc[2], acc[3]), pk2(acc[4], acc[5]), pk2(acc[6], acc[7]));
    }
}
DEVFN void b_lru_wprep(const P& p, const int l, long gid) {
    const int n = (int)(gid / (GW / 8)), k0 = (int)(gid % (GW / 8)) * 8; const int nn = n % GW, blk = nn / LRU_BLK, j = nn % LRU_BLK;
    unsigned w[4] = {0u, 0u, 0u, 0u};
    if (k0 / LRU_BLK == blk) {
        const float* src = (n < GW ? p.lru_wa : p.lru_wx) + ((size_t)l * LRU_NBLK + blk) * LRU_BLK * LRU_BLK + (size_t)(k0 % LRU_BLK) * LRU_BLK + j;
#pragma unroll
        for (int i = 0; i < 4; ++i) w[i] = pk2(src[(2 * i) * LRU_BLK], src[(2 * i + 1) * LRU_BLK]);
    }
    *(uint4*)(p.lruW() + (size_t)n * GW + k0) = make_uint4(w[0], w[1], w[2], w[3]);
}
struct EpiLru {
    static constexpr bool PERM = false, AFTER_DRAIN = false;
    float* LA; float* LB; const bf16_t* xcb; const float* ba; const float* bx; const float* lam;
    __device__ __forceinline__ void operator()(const pg8::f32x4 (&acc)[2][2][4][2], const pg8::Unit& u, int wr, int wc, int fr, int fq) const {
        const int row0 = u.pm * 256 + wr * 64 + fr, col0 = u.pn * 256 + wc * 32 + 4 * fq;
        const bool rg = col0 < GW;
#pragma unroll
        for (int bj = 0; bj < 2; ++bj)
#pragma unroll
            for (int n = 0; n < 2; ++n) {
                const int col = col0 + bj * 128 + n * 16, c = rg ? col : col - GW;
                const pg8::f32x4 bias = *(const pg8::f32x4*)((rg ? ba : bx) + c);
                pg8::f32x4 sp = zero4();
                if (rg) { const pg8::f32x4 lm = *(const pg8::f32x4*)(lam + c);
#pragma unroll
                    for (int j = 0; j < 4; ++j) sp[j] = softplusf_(-lm[j]); }
#pragma unroll
                for (int ai = 0; ai < 2; ++ai)
#pragma unroll
                    for (int m = 0; m < 4; ++m) {
                        const int row = row0 + ai * 128 + m * 16;
                        const pg8::f32x4 v = acc[ai][bj][m][n] + bias;
                        pg8::f32x4 o;
                        if (rg) {
#pragma unroll
                            for (int j = 0; j < 4; ++j) o[j] = -8.0f * sigmoidf_(v[j]) * sp[j];
                            *(pg8::f32x4*)(LA + (size_t)row * GW + c) = o;
                        } else {
                            const uint2 xw = *(const uint2*)(xcb + (size_t)row * GW + c);
                            o[0] = sigmoidf_(v[0]) * __uint_as_float(xw.x << 16); o[1] = sigmoidf_(v[1]) * __uint_as_float(xw.x & 0xffff0000u);
                            o[2] = sigmoidf_(v[2]) * __uint_as_float(xw.y << 16); o[3] = sigmoidf_(v[3]) * __uint_as_float(xw.y & 0xffff0000u);
                            *(pg8::f32x4*)(LB + (size_t)row * GW + c) = o;
                        }
                    }
            }
    }
};
DEVFN void b_lru_wprep2(const P& p, const int l, long gid) {
    const int k0 = (int)(gid & 15) * 8, row = (int)((gid >> 4) & 255), n = (int)(gid >> 12), j = row & 127;
    const float* src = (row < 128 ? p.lru_wa : p.lru_wx) + ((size_t)l * LRU_NBLK + n) * LRU_BLK * LRU_BLK + (size_t)k0 * LRU_BLK + j;
    unsigned w[4];
#pragma unroll
    for (int i = 0; i < 4; ++i) w[i] = pk2(src[(2 * i) * LRU_BLK], src[(2 * i + 1) * LRU_BLK]);
    *(uint4*)(p.lruW() + ((size_t)n * 256 + row) * LRU_BLK + k0) = make_uint4(w[0], w[1], w[2], w[3]);
}
struct DiagOrder {
    int c, G;
    __device__ __forceinline__ bool next(int i, pg8::Unit& u) const { const int idx = i * G + c; if (idx >= LRU_NBLK * (T / 256)) return false; u.pm = idx; u.pn = idx / (T / 256); return true; }
    __device__ __forceinline__ void a_ready(const pg8::Unit&) const {}
    __device__ __forceinline__ void done(const pg8::Unit&) const {}
};
struct EpiLru2 {
    static constexpr bool PERM = false, AFTER_DRAIN = false;
    float* LA; float* LB; const bf16_t* xcb; const float* ba; const float* bx; const float* lam;
    __device__ __forceinline__ void operator()(const pg8::f32x4 (&acc)[2][2][4][2], const pg8::Unit& u, int wr, int wc, int fr, int fq) const {
        const int n = u.pn, row0 = (u.pm - n * (T / 256)) * 256 + wr * 64 + fr, cb = wc * 32 + 4 * fq;
#pragma unroll
        for (int nn = 0; nn < 2; ++nn) {
            const int c = n * LRU_BLK + cb + nn * 16;
            const pg8::f32x4 br = *(const pg8::f32x4*)(ba + c), bi = *(const pg8::f32x4*)(bx + c), lm = *(const pg8::f32x4*)(lam + c);
            pg8::f32x4 sp;
#pragma unroll
            for (int j = 0; j < 4; ++j) sp[j] = -8.0f * softplusf_(-lm[j]);
#pragma unroll
            for (int ai = 0; ai < 2; ++ai)
#pragma unroll
                for (int m = 0; m < 4; ++m) {
                    const int row = row0 + ai * 128 + m * 16;
                    const uint2 xw = *(const uint2*)(xcb + ((size_t)n * T + row) * LRU_BLK + cb + nn * 16);
                    const float xc[4] = {__uint_as_float(xw.x << 16), __uint_as_float(xw.x & 0xffff0000u), __uint_as_float(xw.y << 16), __uint_as_float(xw.y & 0xffff0000u)};
                    const pg8::f32x4 vr = acc[ai][0][m][nn] + br, vi = acc[ai][1][m][nn] + bi;
                    pg8::f32x4 oa, ob;
#pragma unroll
                    for (int j = 0; j < 4; ++j) { const float a = fexp(sigmoidf_(vr[j]) * sp[j]); oa[j] = a; ob[j] = __builtin_amdgcn_sqrtf(fmaxf(1.0f - a * a, 0.0f)) * sigmoidf_(vi[j]) * xc[j]; }
                    *(pg8::f32x4*)(LA + (size_t)row * GW + c) = oa; *(pg8::f32x4*)(LB + (size_t)row * GW + c) = ob;
                }
        }
    }
};
DEVFN void ph_lru_scan(const P& p, const int l, LAS unsigned char* lds, const int u0, const int uend, const int ustep) {
    static_assert(S == 4096, "scan geometry: 64 segments of 64 steps");
    const int tid = tid_fresh(), ch = tid & 7, seg = tid >> 3;
    LAS float* sP = (LAS float*)lds; LAS float* sH = sP + 512;
    for (int u = u0; u < uend; u += ustep) {
        const int b = u / (GW / 8), c = (u % (GW / 8)) * 8 + ch;
        const size_t t0 = (size_t)b * S + (size_t)seg * 64;
        float av[64], bv[64];
        { const float* pa = p.lA() + t0 * GW + c; const float* pb = p.lB() + t0 * GW + c;
#pragma unroll
          for (int i = 0; i < 64; ++i) { av[i] = *pa; bv[i] = *pb; pa += GW; pb += GW; asm volatile("" : "+v"(pa), "+v"(pb)); } }
        float Pp = 1.f, H = 0.f;
#pragma unroll
        for (int i = 0; i < 64; ++i) { const float a = av[i]; H = a * H + bv[i]; Pp *= a; }
        sP[seg * 8 + ch] = Pp; sH[seg * 8 + ch] = H;
        __syncthreads();
        float h = 0.f;
        for (int s2 = 0; s2 < seg; ++s2) h = sP[s2 * 8 + ch] * h + sH[s2 * 8 + ch];
        LAS unsigned char* hb = lds + 4096;
#pragma unroll
        for (int i = 0; i < 64; ++i) { h = av[i] * h + bv[i]; *(LAS bf16_t*)(hb + seg * 1040 + i * 16 + ch * 2) = (bf16_t)(pk2(h, 0.f) & 0xffffu); }
        __syncthreads();
        {
            const int cb = (u % (GW / 8)) * 8;
#pragma unroll
            for (int i = 0; i < S / 512; ++i) {
                const int tk = tid + 512 * i; const size_t t = (size_t)b * S + tk;
                const uint4 gw = *(const uint4*)(p.pjb() + t * PLD + C_LRUG + cb); const u32x4v hw = *(const LAS u32x4v*)(hb + (tk >> 6) * 1040 + (tk & 63) * 16);
                const unsigned g4[4] = {gw.x, gw.y, gw.z, gw.w}; const unsigned h4[4] = {hw.x, hw.y, hw.z, hw.w}; float o8[8];
#pragma unroll
                for (int j = 0; j < 4; ++j) { o8[2 * j] = __uint_as_float(h4[j] << 16) * gelu_tanhf_(__uint_as_float(g4[j] << 16)) * F8S_M; o8[2 * j + 1] = __uint_as_float(h4[j] & 0xffff0000u) * gelu_tanhf_(__uint_as_float(g4[j] & 0xffff0000u)) * F8S_M; }
                *(uint2*)((unsigned char*)p.mixedb() + t * D + cb) = make_uint2(pk4f8(o8[0], o8[1], o8[2], o8[3]), pk4f8(o8[4], o8[5], o8[6], o8[7]));
            }
        }
        __syncthreads();
    }
}

static_assert(S5_P == 64 && S5_HG == 16 && S5_G == 64 && S == 4096, "S5 phases are written for 64 groups x 16 channels, 64 complex states, 64 chunks of 64 tokens");
constexpr int S5_L = 64, S5_NCH = S / S5_L, S5_K = S5_L * S5_HG  , S5_P2 = 2 * S5_P  ;
DEVFN void b_s5_pre2(const P& p, const int l, long gid) {
    const int g = (int)(gid / S5_P);
    const float step = expf(p.s5_log_step[(size_t)l * S5_G + g]);
    const float lr = p.s5_a_re[(size_t)l * S5_GP + gid], li = p.s5_a_im[(size_t)l * S5_GP + gid];
    const float mag = expf(lr * step), ang = li * step;
    const float are = mag * cosf(ang), aim = mag * sinf(ang);
    const float den = lr * lr + li * li;
    const float fre = ((are - 1.0f) * lr + aim * li) / den, fim = (aim * lr - (are - 1.0f) * li) / den;
    for (int h = 0; h < S5_HG; ++h) {
        const float br = p.s5_b_re[((size_t)l * S5_GP + gid) * S5_HG + h], bi = p.s5_b_im[((size_t)l * S5_GP + gid) * S5_HG + h];
        p.s5bb()[(gid * S5_HG + h) * 2] = fre * br - fim * bi; p.s5bb()[(gid * S5_HG + h) * 2 + 1] = fre * bi + fim * br;
    }
}
DEVFN void b_s5_pw(const P& p, const int l, long gid) {
    const long gp = gid / (S5_L + 1); const int k = (int)(gid % (S5_L + 1)), g = (int)(gp / S5_P);
    const float step = expf(p.s5_log_step[(size_t)l * S5_G + g]);
    const float lr = p.s5_a_re[(size_t)l * S5_GP + gp], li = p.s5_a_im[(size_t)l * S5_GP + gp];
    const float mk = expf((float)k * (lr * step)), ak = (float)k * (li * step);
    p.s5pw()[gid * 2] = mk * cosf(ak); p.s5pw()[gid * 2 + 1] = mk * sinf(ak);
}
DEVFN void b_s5_ktoep(const P& p, const int l, long gid) {
    const int hp = (int)(gid & 15), h = (int)((gid >> 4) & 15), tau = (int)((gid >> 8) & 63), g = (int)(gid >> 14);
    const float* cr = p.s5_c_re + (((size_t)l * S5_G + g) * S5_HG + h) * S5_P; const float* ci = p.s5_c_im + (((size_t)l * S5_G + g) * S5_HG + h) * S5_P;
    float acc = 0.f;
    for (int q = 0; q < S5_P; ++q) {
        const size_t gp = (size_t)g * S5_P + q;
        const float wr = p.s5pw()[(gp * (S5_L + 1) + tau) * 2], wi = p.s5pw()[(gp * (S5_L + 1) + tau) * 2 + 1];
        const float br = p.s5bb()[(gp * S5_HG + hp) * 2], bi = p.s5bb()[(gp * S5_HG + hp) * 2 + 1];
        const float xr = cr[q] * wr - ci[q] * wi, xi = cr[q] * wi + ci[q] * wr;
        acc += xr * br - xi * bi;
    }
    p.s5kt()[gid] = (bf16_t)(pk2(acc, 0.f) & 0xffffu);
}
DEVFN void ph_s5_ktoep(const P& p, const int l, LAS unsigned char* lds, const int first, const int cnt) {
    const int tid = tid_fresh(); const int vb = bid_fresh() - first;
    if (vb < 0 || vb >= cnt) return;
    typedef float f32x2_ __attribute__((ext_vector_type(2)));
    LAS f32x2_* pwl = (LAS f32x2_*)lds;
    LAS float* part = (LAS float*)(lds + 32768);
    const int pair = tid & 255, h = pair >> 4, hp = pair & 15, ph = tid >> 8, q0 = ph * 32;
    for (int g = vb; g < S5_G; g += cnt) {
        for (int i = tid; i < S5_P * S5_L; i += 512) { const int q = i >> 6, tau = i & 63; const float* src = p.s5pw() + (((size_t)g * S5_P + q) * (S5_L + 1) + tau) * 2; pwl[tau * 64 + q] = (f32x2_){src[0], src[1]}; }
        float zr[32], zi[32];
        const float* cr = p.s5_c_re + (((size_t)l * S5_G + g) * S5_HG + h) * S5_P + q0; const float* ci = p.s5_c_im + (((size_t)l * S5_G + g) * S5_HG + h) * S5_P + q0;
#pragma unroll
        for (int q = 0; q < 32; ++q) {
            const float br = p.s5bb()[(((size_t)g * S5_P + q0 + q) * S5_HG + hp) * 2], bi = p.s5bb()[(((size_t)g * S5_P + q0 + q) * S5_HG + hp) * 2 + 1];
            zr[q] = cr[q] * br - ci[q] * bi; zi[q] = cr[q] * bi + ci[q] * br;
        }
        __syncthreads();
        if (ph == 1) {
#pragma unroll 1
            for (int tau = 0; tau < S5_L; ++tau) {
                float acc = 0.f;
#pragma unroll
                for (int q = 0; q < 32; ++q) { const f32x2_ w = pwl[tau * 64 + 32 + q]; acc += zr[q] * w.x - zi[q] * w.y; }
                part[tau * 256 + pair] = acc;
            }
        }
        __syncthreads();
        if (ph == 0) {
#pragma unroll 1
            for (int tau = 0; tau < S5_L; ++tau) {
                float acc = part[tau * 256 + pair];
#pragma unroll
                for (int q = 0; q < 32; ++q) { const f32x2_ w = pwl[tau * 64 + q]; acc += zr[q] * w.x - zi[q] * w.y; }
                p.s5kt()[(((size_t)g * S5_L + tau) * S5_HG + h) * S5_HG + hp] = (bf16_t)(pk2(acc, 0.f) & 0xffffu);
            }
        }
        __syncthreads();
    }
}
DEVFN void b_s5_wend(const P& p, const int l, long gid) {
    const int k0 = (int)(gid & 127) * 8, p2 = (int)((gid >> 7) & 127), g = (int)(gid >> 14);
    const int q = p2 & 63, im = p2 >> 6, s = k0 >> 4, h0 = k0 & 15;
    const size_t gp = (size_t)g * S5_P + q;
    const float wr = p.s5pw()[(gp * (S5_L + 1) + (63 - s)) * 2], wi = p.s5pw()[(gp * (S5_L + 1) + (63 - s)) * 2 + 1];
    float v[8];
#pragma unroll
    for (int i = 0; i < 8; ++i) { const float br = p.s5bb()[(gp * S5_HG + h0 + i) * 2], bi = p.s5bb()[(gp * S5_HG + h0 + i) * 2 + 1]; v[i] = im ? (wr * bi + wi * br) : (wr * br - wi * bi); }
    *(uint4*)(p.s5we() + ((size_t)g * S5_P2 + p2) * S5_K + k0) = make_uint4(pk2(v[0], v[1]), pk2(v[2], v[3]), pk2(v[4], v[5]), pk2(v[6], v[7]));
}
DEVFN void b_s5_mc(const P& p, const int l, long gid) {
    const int p0 = (int)(gid & 15) * 8, n = (int)((gid >> 4) & 1023), g = (int)(gid >> 14);
    const int t = n >> 4, h = n & 15, im = p0 >> 6, q0 = p0 & 63;
    const float* cr = p.s5_c_re + (((size_t)l * S5_G + g) * S5_HG + h) * S5_P + q0; const float* ci = p.s5_c_im + (((size_t)l * S5_G + g) * S5_HG + h) * S5_P + q0;
    float v[8];
#pragma unroll
    for (int i = 0; i < 8; ++i) {
        const size_t gp = (size_t)g * S5_P + q0 + i;
        const float wr = p.s5pw()[(gp * (S5_L + 1) + t + 1) * 2], wi = p.s5pw()[(gp * (S5_L + 1) + t + 1) * 2 + 1];
        v[i] = im ? -(cr[i] * wi + ci[i] * wr) : (cr[i] * wr - ci[i] * wi);
    }
    *(uint4*)(p.s5mc() + ((size_t)g * S5_K + n) * S5_P2 + p0) = make_uint4(pk2(v[0], v[1]), pk2(v[2], v[3]), pk2(v[4], v[5]), pk2(v[6], v[7]));
}
DEVFN void ph_s5_e(const P& p, const int l) {
    const int tid = tid_fresh(), w = __builtin_amdgcn_readfirstlane(tid >> 6), lane = tid & 63, l15 = lane & 15, quad = lane >> 4;
    for (int u_ = bid_fresh(); u_ < NB * S5_G * 2; u_ += gridDim.x) {
        const int u = (gridDim.x == 256) ? ((u_ & 7) * 32 + (u_ >> 3)) : u_;
        const int half = u & 1, ug = u >> 1, b = ug / S5_G, g = ug % S5_G, mi = 2 * half + (w >> 2), nh = (w >> 1) & 1, n0 = 2 * (w & 1);
        const bf16_t* ap = p.pjb() + ((size_t)b * S + (size_t)(16 * mi + l15) * S5_L + (quad >> 1)) * PLD + C_S5U + g * S5_HG + (quad & 1) * 8;
        const bf16_t* bp = p.s5we() + ((size_t)g * S5_P2 + 64 * nh + 16 * n0 + l15) * S5_K + quad * 8;
        f32x4 acc[2];
#pragma unroll
        for (int ni = 0; ni < 2; ++ni) acc[ni] = zero4();
#pragma unroll 4
        for (int ks = 0; ks < 32; ++ks) {
            const bf16x8 af = *(const bf16x8*)(ap + (size_t)(2 * ks) * PLD);
#pragma unroll
            for (int ni = 0; ni < 2; ++ni) { const bf16x8 bfr = *(const bf16x8*)(bp + (size_t)(16 * ni) * S5_K + 32 * ks); acc[ni] = __builtin_amdgcn_mfma_f32_16x16x32_bf16(af, bfr, acc[ni], 0, 0, 0); }
        }
        float* eo = p.s5el() + ((size_t)ug * S5_NCH) * S5_P2;
#pragma unroll
        for (int ni = 0; ni < 2; ++ni)
#pragma unroll
            for (int j = 0; j < 4; ++j) eo[(size_t)(16 * mi + quad * 4 + j) * S5_P2 + 64 * nh + 16 * (n0 + ni) + l15] = acc[ni][j];
    }
}
constexpr int S5Y_UP = 2064;
DEVFN void ph_s5_y(const P& p, const int l, LAS unsigned char* lds) {
    const int tid = tid_fresh(), w = __builtin_amdgcn_readfirstlane(tid >> 6), lane = tid & 63, l15 = lane & 15, quad = lane >> 4;
    LAS unsigned char* Ut = lds;
    LAS unsigned char* Kt = lds + 32 * S5Y_UP;
    LAS unsigned char* Ei = Kt + 32768;
    for (int u_ = bid_fresh(); u_ < NB * S5_G * 2; u_ += gridDim.x) {
        const int u = (gridDim.x == 256) ? ((u_ & 7) * 32 + (u_ >> 3)) : u_;
        const int half = u & 1, g = (u >> 1) % S5_G, b = u / (2 * S5_G);
#pragma unroll
        for (int i = 0; i < 8; ++i) {
            const int q = tid + 512 * i, r = q >> 7, s = (q >> 1) & 63, hh = q & 1;
            *(LAS u32x4v*)(Ut + r * S5Y_UP + (s * 16 + hh * 8) * 2) = *(const u32x4v*)(p.pjb() + ((size_t)b * S + (size_t)(32 * half + r) * S5_L + s) * PLD + C_S5U + g * S5_HG + hh * 8);
        }
#pragma unroll
        for (int i = 0; i < 4; ++i) *(LAS u32x4v*)(Kt + (tid + 512 * i) * 16) = *(const u32x4v*)(p.s5kt() + (size_t)g * 16384 + (size_t)(tid + 512 * i) * 8);
        {
            const int q = lane, L = 4 * (half + 1);
            const size_t gp = (size_t)g * S5_P + q;
            const float ar = p.s5pw()[(gp * (S5_L + 1) + S5_L) * 2], ai = p.s5pw()[(gp * (S5_L + 1) + S5_L) * 2 + 1];
            const float* el = p.s5el() + ((size_t)(b * S5_G + g) * S5_NCH + (size_t)w * L) * S5_P2;
            float lr_[8], li_[8], pr[8], pi[8];
#pragma unroll
            for (int j = 0; j < 8; ++j) if (j < L) { lr_[j] = el[(size_t)j * S5_P2 + q]; li_[j] = el[(size_t)j * S5_P2 + 64 + q]; }
            float er = 0.f, ei = 0.f;
#pragma unroll
            for (int j = 0; j < 8; ++j) if (j < L) { pr[j] = er; pi[j] = ei; const float nr = ar * er - ai * ei + lr_[j], ni = ar * ei + ai * er + li_[j]; er = nr; ei = ni; }
            LAS float* xch = (LAS float*)(Ei + 32 * 272);
            xch[(w * 64 + q) * 2] = er; xch[(w * 64 + q) * 2 + 1] = ei;
            float br = ar * ar - ai * ai, bi = 2.f * ar * ai;
            { const float t2 = br * br - bi * bi; bi = 2.f * br * bi; br = t2; }
            if (half) { const float t2 = br * br - bi * bi; bi = 2.f * br * bi; br = t2; }
            __syncthreads();
            float cr = 0.f, ci = 0.f;
            for (int j = 0; j < w; ++j) { const float xr = xch[(j * 64 + q) * 2], xi = xch[(j * 64 + q) * 2 + 1]; const float nr = br * cr - bi * ci + xr, ni = br * ci + bi * cr + xi; cr = nr; ci = ni; }
#pragma unroll
            for (int j = 0; j < 8; ++j) if (j < L) {
                const int n = w * L + j;
                if (n >= 32 * half) { *(LAS bf16_t*)(Ei + (n - 32 * half) * 272 + q * 2) = (bf16_t)(pk2(cr + pr[j], 0.f) & 0xffffu); *(LAS bf16_t*)(Ei + (n - 32 * half) * 272 + (64 + q) * 2) = (bf16_t)(pk2(ci + pi[j], 0.f) & 0xffffu); }
                const float nr = ar * cr - ai * ci, ni = ar * ci + ai * cr; cr = nr; ci = ni;
            }
        }
        __syncthreads();
        const float dcoef = p.s5_d[(size_t)l * GW + g * S5_HG + l15];
        f32x4 acc[8][2];
#pragma unroll
        for (int tt = 0; tt < 8; ++tt) { acc[tt][0] = zero4(); acc[tt][1] = zero4(); }
        const int ksmax = ((w + 56) >> 1) + 1;
#pragma unroll 1
        for (int ks = 0; ks < ksmax; ++ks) {
            const bf16x8 a0 = *(const LAS bf16x8*)(Ut + l15 * S5Y_UP + 64 * ks + quad * 16), a1 = *(const LAS bf16x8*)(Ut + (16 + l15) * S5Y_UP + 64 * ks + quad * 16);
#pragma unroll
            for (int tt = 0; tt < 8; ++tt) {
                const int t = w + 8 * tt;
                if ((t >> 1) >= ks) {
                    const int tau = t - (2 * ks + (quad >> 1));
                    u32x4v kw = zero4u();
                    if (tau >= 0) kw = *(const LAS u32x4v*)(Kt + ((tau * 16 + l15) * 16 + (quad & 1) * 8) * 2);
                    const bf16x8 bfr = __builtin_bit_cast(bf16x8, kw);
                    acc[tt][0] = __builtin_amdgcn_mfma_f32_16x16x32_bf16(a0, bfr, acc[tt][0], 0, 0, 0); acc[tt][1] = __builtin_amdgcn_mfma_f32_16x16x32_bf16(a1, bfr, acc[tt][1], 0, 0, 0);
                }
            }
        }
#pragma unroll
        for (int tt = 0; tt < 8; ++tt) {
            const int t = w + 8 * tt;
            const bf16_t* mp = p.s5mc() + ((size_t)g * S5_K + t * 16 + l15) * S5_P2 + quad * 8;
#pragma unroll
            for (int ks = 0; ks < 4; ++ks) {
                const bf16x8 bfr = *(const bf16x8*)(mp + 32 * ks);
                const bf16x8 a0 = *(const LAS bf16x8*)(Ei + l15 * 272 + 64 * ks + quad * 16), a1 = *(const LAS bf16x8*)(Ei + (16 + l15) * 272 + 64 * ks + quad * 16);
                acc[tt][0] = __builtin_amdgcn_mfma_f32_16x16x32_bf16(a0, bfr, acc[tt][0], 0, 0, 0); acc[tt][1] = __builtin_amdgcn_mfma_f32_16x16x32_bf16(a1, bfr, acc[tt][1], 0, 0, 0);
            }
#pragma unroll
            for (int mi = 0; mi < 2; ++mi)
#pragma unroll
                for (int j = 0; j < 4; ++j) {
                    const int r = 16 * mi + quad * 4 + j;
                    const float uu = bf2f(*(const LAS bf16_t*)(Ut + r * S5Y_UP + (t * 16 + l15) * 2));
                    const float y = acc[tt][mi][j] + dcoef * uu;
                    p.s5zb()[((size_t)b * S + (size_t)(32 * half + r) * S5_L + t) * GW + g * S5_HG + l15] = (bf16_t)(pk2(gelu_tanhf_(y), 0.f) & 0xffffu);
                }
        }
        __syncthreads();
    }
}
struct EpiGlu {
    static constexpr bool PERM = true, AFTER_DRAIN = false;
    unsigned char* O; const bf16_t* Z; const float* bias; int ldo; int ldz;
    __device__ __forceinline__ void operator()(const pg8::f32x4 (&acc)[2][2][4][2], const pg8::Unit& u, int wr, int wc, int fr, int fq) const {
        const int row0 = u.pm * 256 + wr * 64 + fr, col0 = u.pn * 256 + wc * 32 + 8 * fq;
#pragma unroll
        for (int bj = 0; bj < 2; ++bj) {
            const int col = col0 + bj * 128;
            const pg8::f32x4 b0 = *(const pg8::f32x4*)(bias + col), b1 = *(const pg8::f32x4*)(bias + col + 4);
#pragma unroll
            for (int ai = 0; ai < 2; ++ai)
#pragma unroll
                for (int m = 0; m < 4; ++m) {
                    const int row = row0 + ai * 128 + m * 16;
                    const pg8::u32x4 zw = *(const pg8::u32x4*)(Z + (size_t)row * ldz + col);
                    const pg8::f32x4 v0 = acc[ai][bj][m][0] + b0, v1 = acc[ai][bj][m][1] + b1;
                    u32x2v o;
                    o.x = pk4f8(__uint_as_float(zw.x << 16) * (sigmoidf_(v0[0]) * F8S_M), __uint_as_float(zw.x & 0xffff0000u) * (sigmoidf_(v0[1]) * F8S_M), __uint_as_float(zw.y << 16) * (sigmoidf_(v0[2]) * F8S_M), __uint_as_float(zw.y & 0xffff0000u) * (sigmoidf_(v0[3]) * F8S_M));
                    o.y = pk4f8(__uint_as_float(zw.z << 16) * (sigmoidf_(v1[0]) * F8S_M), __uint_as_float(zw.z & 0xffff0000u) * (sigmoidf_(v1[1]) * F8S_M), __uint_as_float(zw.w << 16) * (sigmoidf_(v1[2]) * F8S_M), __uint_as_float(zw.w & 0xffff0000u) * (sigmoidf_(v1[3]) * F8S_M));
                    *(u32x2v*)(O + (size_t)row * ldo + col) = o;
                }
        }
    }
};

DEVFN unsigned f2ord(float f) { const unsigned u = __float_as_uint(f); return u ^ ((u >> 31) ? 0xFFFFFFFFu : 0x80000000u); }
constexpr int PER_TT = 32, PER_SP = 129;
DEVFN void ph_pe_route(const P& p, const int l, LAS unsigned char* lds, const bool dry = false) {
    static_assert(PE_NK == 128 && PE_K == 16 && PE_DH == 128, "routing phase is written for 128 sub-keys of width 128, top-16");
    const int tid = tid_fresh(), w = __builtin_amdgcn_readfirstlane(tid >> 6), lane = tid & 63, l15 = lane & 15, quad = lane >> 4, half = lane >> 5, li = lane & 31;
    LAS float* Ssm = (LAS float*)lds;
    int ca = 0, cstart = 0;
    {
        const int th[15] = {16, 24, 29, 33, 36, 38, 40, 42, 43, 44, 45, 46, 47, 48, 49};
#pragma unroll
        for (int i = 0; i < 15; ++i) if (lane >= th[i]) { ca = i + 1; cstart = th[i]; }
    }
    const int cb = lane - cstart; const bool cvalid = lane < 50; const unsigned cflat = (unsigned)(ca * 16 + (cb & 15));
    for (int u = bid_fresh(); u < T / PER_TT; u += gridDim.x) {
        const int tok0 = u * PER_TT;
#pragma unroll 1
        for (int h = 0; h < PE_H; ++h) {
            {
                const int c = w >> 2, ntp = w & 3;
                const bf16_t* qb = p.pqb() + (size_t)(tok0 + l15) * PE_QW + (h * 2 + c) * PE_DH + quad * 8;
                const bf16_t* sb = p.skb() + (((size_t)(h * 2 + c)) * PE_NK + 32 * ntp + l15) * PE_DH + quad * 8;
                bf16x8 bfr[2][4];
#pragma unroll
                for (int n2 = 0; n2 < 2; ++n2)
#pragma unroll
                    for (int ks = 0; ks < 4; ++ks) bfr[n2][ks] = *(const bf16x8*)(sb + (size_t)n2 * 16 * PE_DH + 32 * ks);
#pragma unroll
                for (int mt = 0; mt < 2; ++mt) {
                    bf16x8 afr[4];
#pragma unroll
                    for (int ks = 0; ks < 4; ++ks) afr[ks] = *(const bf16x8*)(qb + (size_t)mt * 16 * PE_QW + 32 * ks);
                    f32x4 a0 = zero4(), a1 = a0;
#pragma unroll
                    for (int ks = 0; ks < 4; ++ks) { a0 = __builtin_amdgcn_mfma_f32_16x16x32_bf16(afr[ks], bfr[0][ks], a0, 0, 0, 0); a1 = __builtin_amdgcn_mfma_f32_16x16x32_bf16(afr[ks], bfr[1][ks], a1, 0, 0, 0); }
#pragma unroll
                    for (int e = 0; e < 4; ++e) { LAS float* r = Ssm + (c * PER_TT + 16 * mt + quad * 4 + e) * PER_SP + 32 * ntp + l15; r[0] = a0[e]; r[16] = a1[e]; }
                }
            }
            __syncthreads();
#pragma unroll 1
            for (int tt = 0; tt < PER_TT / 8; tt += 2) {
                int tl[2]; size_t t[2]; float rstd[2]; const LAS float* row[2]; unsigned pk[2][4]; int myidx[2] = {0, 0};
#pragma unroll
                for (int z = 0; z < 2; ++z) {
                    tl[z] = (PER_TT / 8) * w + tt + z; t[z] = (size_t)tok0 + tl[z];
                    float rsum = dpp_rowsum_f(p.ssp()[t[z] * 64 + lane]);
                    { const int ri = __float_as_int(rsum);
                      rsum = (__int_as_float(__builtin_amdgcn_readlane(ri, 0)) + __int_as_float(__builtin_amdgcn_readlane(ri, 16))) + (__int_as_float(__builtin_amdgcn_readlane(ri, 32)) + __int_as_float(__builtin_amdgcn_readlane(ri, 48))); }
                    if (h == 0 && lane == 0) p.sumsq()[t[z]] = rsum;
                    rstd[z] = 1.0f / sqrtf(rsum * (1.0f / (float)D) + RMS_EPS);
                    row[z] = Ssm + (half * PER_TT + tl[z]) * PER_SP;
#pragma unroll
                    for (int k = 0; k < 4; ++k) pk[z][k] = (f2ord(row[z][li + 32 * k]) & ~127u) | (unsigned)(127 - (li + 32 * k));
                }
#pragma unroll 1
                for (int r = 0; r < 16; ++r) {
#pragma unroll
                    for (int z = 0; z < 2; ++z) {
                        const unsigned m = xrow16_max_u(dpp_rowmax_u(max(max(pk[z][0], pk[z][1]), max(pk[z][2], pk[z][3]))));
#pragma unroll
                        for (int k = 0; k < 4; ++k) pk[z][k] = (pk[z][k] == m) ? 0u : pk[z][k];
                        if (li == r) myidx[z] = 127 - (int)(m & 127u);
                    }
                }
                float myval[2]; unsigned ck[2], myflat[2] = {0u, 0u};
#pragma unroll
                for (int z = 0; z < 2; ++z) {
                    myval[z] = row[z][myidx[z]];
                    const float csum = __shfl(myval[z], ca) + __shfl(myval[z], 32 + (cb & 15));
                    ck[z] = cvalid ? ((f2ord(csum) & ~255u) | (255u - cflat)) : 0u;
                }
#pragma unroll 1
                for (int r = 0; r < 16; ++r) {
#pragma unroll
                    for (int z = 0; z < 2; ++z) {
                        const unsigned m = xrow32_max_u(xrow16_max_u(dpp_rowmax_u(ck[z])));
                        ck[z] = (ck[z] == m) ? 0u : ck[z];
                        if (lane == r) myflat[z] = 255u - (m & 255u);
                    }
                }
#pragma unroll
                for (int z = 0; z < 2; ++z) {
                    const int sa = (int)(myflat[z] >> 4) & 15, sb2 = (int)myflat[z] & 15;
                    const float sc = (__shfl(myval[z], sa) + __shfl(myval[z], 32 + sb2)) * rstd[z];
                    const int ex_id = __shfl(myidx[z], sa) * PE_NK + __shfl(myidx[z], 32 + sb2);
                    const float mx = dpp_rowmax_f(sc);
                    const float ev = expf(sc - mx); const float sm = dpp_rowsum_f(ev);
                    if (lane < 16 && !dry) { p.pli()[t[z] * PE_HK + h * PE_K + lane] = ex_id; p.plg()[t[z] * PE_HK + h * PE_K + lane] = ev / sm; }
                }
            }
            __syncthreads();
        }
    }
}
struct EpiPeer1A {
    static constexpr bool PERM = true, AFTER_DRAIN = false;
    bf16_t* A; unsigned char* Pm; const float* sumsq; int ld; int pad;
    __device__ __forceinline__ void operator()(const pg8::f32x4 (&acc)[2][2][4][2], const pg8::Unit& u, int wr, int wc, int fr, int fq) const {
        const int row0 = u.pm * 256 + wr * 64 + fr, col0 = u.pn * 256 + wc * 32 + 8 * fq;
#pragma unroll
        for (int ai = 0; ai < 2; ++ai)
#pragma unroll
            for (int m = 0; m < 4; ++m) {
                const int row = row0 + ai * 128 + m * 16;
                const float sc = (1.0f / (F8S_X * F8S_U)) / sqrtf(sumsq[row] * (1.0f / (float)D) + RMS_EPS);
#pragma unroll
                for (int bj = 0; bj < 2; ++bj) {
                    const size_t o = (size_t)row * ld + col0 + bj * 128;
                    const pg8::f32x4 v0 = acc[ai][bj][m][0] * sc, v1 = acc[ai][bj][m][1] * sc;
                    pg8::u32x4 wv; wv.x = pk2(v0[0], v0[1]); wv.y = pk2(v0[2], v0[3]); wv.z = pk2(v1[0], v1[1]); wv.w = pk2(v1[2], v1[3]);
                    *(pg8::u32x4*)(A + o) = wv;
                    *(uint2*)(Pm + o) = make_uint2(0u, 0u);
                }
            }
    }
};
DEVFN void ph_pe_apply(const P& p, LAS unsigned char* lds) {
    const int tid = tid_fresh(), w = __builtin_amdgcn_readfirstlane(tid >> 6), lane = tid & 63;
    LAS unsigned* bm = (LAS unsigned*)(lds + w * 2048);
#pragma unroll
    for (int i = 0; i < 8; ++i) bm[lane + 64 * i] = 0u;
    const int tstep = 8 * (int)gridDim.x;
    for (int tb = bid_fresh() + (int)gridDim.x * w; tb < T; tb += 4 * tstep) {
        int e0a[4], e1a[4]; float g0a[4], g1a[4]; bf16_t a0a[4], a1a[4];
#pragma unroll
        for (int k = 0; k < 4; ++k) { const int t = tb + k * tstep; e0a[k] = 0; e1a[k] = 0; g0a[k] = 0.f; g1a[k] = 0.f;
            if (t < T) { e0a[k] = p.pli()[(size_t)t * PE_HK + lane]; e1a[k] = p.pli()[(size_t)t * PE_HK + 64 + lane]; g0a[k] = p.plg()[(size_t)t * PE_HK + lane]; g1a[k] = p.plg()[(size_t)t * PE_HK + 64 + lane]; } }
#pragma unroll
        for (int k = 0; k < 4; ++k) { const int t = tb + k * tstep; a0a[k] = 0; a1a[k] = 0; if (t < T) { a0a[k] = p.A16()[(size_t)t * PE_E + e0a[k]]; a1a[k] = p.A16()[(size_t)t * PE_E + e1a[k]]; } }
#pragma unroll
        for (int k = 0; k < 4; ++k) {
            const int t = tb + k * tstep;
            if (t < T) {
                const int e0 = e0a[k], e1 = e1a[k]; const float g0 = g0a[k], g1 = g1a[k];
                const unsigned b0 = 1u << (e0 & 31), b1 = 1u << (e1 & 31);
                const unsigned o0 = __hip_atomic_fetch_or(bm + (e0 >> 5), b0, __ATOMIC_RELAXED, __HIP_MEMORY_SCOPE_WORKGROUP);
                const unsigned o1 = __hip_atomic_fetch_or(bm + (e1 >> 5), b1, __ATOMIC_RELAXED, __HIP_MEMORY_SCOPE_WORKGROUP);
                float s0 = g0, s1 = g1; bool f0 = true, f1 = true;
                unsigned long long m0 = __builtin_amdgcn_ballot_w64((o0 & b0) != 0u), m1 = __builtin_amdgcn_ballot_w64((o1 & b1) != 0u);
                while ((m0 | m1) != 0ull) {
                    int idd;
                    if (m0 != 0ull) { const int ln = __builtin_ctzll(m0); m0 &= m0 - 1ull; idd = __builtin_amdgcn_readlane(e0, ln); }
                    else { const int ln = __builtin_ctzll(m1); m1 &= m1 - 1ull; idd = __builtin_amdgcn_readlane(e1, ln); }
                    const unsigned long long q0 = __builtin_amdgcn_ballot_w64(e0 == idd), q1 = __builtin_amdgcn_ballot_w64(e1 == idd);
                    float sum = 0.f;
                    for (unsigned long long r = q0; r != 0ull; r &= r - 1ull) sum += __int_as_float(__builtin_amdgcn_readlane(__float_as_int(g0), __builtin_ctzll(r)));
                    for (unsigned long long r = q1; r != 0ull; r &= r - 1ull) sum += __int_as_float(__builtin_amdgcn_readlane(__float_as_int(g1), __builtin_ctzll(r)));
                    const bool in0 = q0 != 0ull; const int fl = in0 ? __builtin_ctzll(q0) : __builtin_ctzll(q1);
                    if (e0 == idd) { if (in0 && lane == fl) s0 = sum; else f0 = false; }
                    if (e1 == idd) { if (!in0 && lane == fl) s1 = sum; else f1 = false; }
                }
                if (f0) p.P8()[(size_t)t * PE_E + e0] = (unsigned char)(pk4f8(s0 * gelu_erff_(bf2f(a0a[k])) * F8S_P, 0.f, 0.f, 0.f) & 0xffu);
                if (f1) p.P8()[(size_t)t * PE_E + e1] = (unsigned char)(pk4f8(s1 * gelu_erff_(bf2f(a1a[k])) * F8S_P, 0.f, 0.f, 0.f) & 0xffu);
                bm[e0 >> 5] = 0u; bm[e1 >> 5] = 0u;
            }
        }
    }
}
struct EpiPeer1F8 {
    static constexpr bool PERM = true, AFTER_DRAIN = false;
    unsigned char* Pm; const bf16_t* G; const float* sumsq; int ld; int pad;
    __device__ __forceinline__ void operator()(const pg8::f32x4 (&acc)[2][2][4][2], const pg8::Unit& u, int wr, int wc, int fr, int fq) const {
        const int row0 = u.pm * 256 + wr * 64 + fr, col0 = u.pn * 256 + wc * 32 + 8 * fq;
#pragma unroll
        for (int ai = 0; ai < 2; ++ai) {
            pg8::u32x4 gw[4][2]; float ssq[4];
#pragma unroll
            for (int m = 0; m < 4; ++m) {
                const int row = row0 + ai * 128 + m * 16; ssq[m] = sumsq[row];
#pragma unroll
                for (int bj = 0; bj < 2; ++bj) gw[m][bj] = *(const pg8::u32x4*)(G + (size_t)row * ld + col0 + bj * 128);
            }
            asm volatile("" ::: "memory");
#pragma unroll
            for (int m = 0; m < 4; ++m) {
                const int row = row0 + ai * 128 + m * 16;
                const float sc = (1.0f / (F8S_X * F8S_U)) / sqrtf(ssq[m] * (1.0f / (float)D) + RMS_EPS);
#pragma unroll
                for (int bj = 0; bj < 2; ++bj) {
                    const size_t o = (size_t)row * ld + col0 + bj * 128;
                    const pg8::u32x4 g4 = gw[m][bj];
                    const pg8::f32x4 v0 = acc[ai][bj][m][0] * sc, v1 = acc[ai][bj][m][1] * sc;
                    const pg8::f32x2 a = pg8::gelu_pk((pg8::f32x2){v0[0], v0[1]}), b = pg8::gelu_pk((pg8::f32x2){v0[2], v0[3]}),
                                     c = pg8::gelu_pk((pg8::f32x2){v1[0], v1[1]}), d = pg8::gelu_pk((pg8::f32x2){v1[2], v1[3]});
                    const unsigned w0 = pk4f8(a.x * F8S_P * __uint_as_float(g4.x << 16), a.y * F8S_P * __uint_as_float(g4.x & 0xffff0000u), b.x * F8S_P * __uint_as_float(g4.y << 16), b.y * F8S_P * __uint_as_float(g4.y & 0xffff0000u));
                    const unsigned w1 = pk4f8(c.x * F8S_P * __uint_as_float(g4.z << 16), c.y * F8S_P * __uint_as_float(g4.z & 0xffff0000u), d.x * F8S_P * __uint_as_float(g4.w << 16), d.y * F8S_P * __uint_as_float(g4.w & 0xffff0000u));
                    *(uint2*)(Pm + o) = make_uint2(w0, w1);
                }
            }
        }
    }
};
struct EpiF32C {
    static constexpr bool PERM = false, AFTER_DRAIN = false;
    float* C; const float* R; float cs; int ld;
    __device__ __forceinline__ void operator()(const pg8::f32x4 (&acc)[2][2][4][2], const pg8::Unit& u, int wr, int wc, int fr, int fq) const {
        const int row0 = u.pm * 256 + wr * 64 + fr, col0 = u.pn * 256 + wc * 32 + 4 * fq;
#pragma unroll
        for (int ai = 0; ai < 2; ++ai)
#pragma unroll
            for (int m = 0; m < 4; ++m)
#pragma unroll
                for (int bj = 0; bj < 2; ++bj)
#pragma unroll
                    for (int n = 0; n < 2; ++n) {
                        const size_t o = (size_t)(row0 + ai * 128 + m * 16) * ld + col0 + bj * 128 + n * 16;
                        *(pg8::f32x4*)(C + o) = acc[ai][bj][m][n] * cs + *(const pg8::f32x4*)(R + o);
                    }
    }
};
struct EpiResid {
    static constexpr bool PERM = false, AFTER_DRAIN = false;
    bf16_t* Xb; unsigned char* X8; float* part; float cs; int ld;
    __device__ __forceinline__ void operator()(const pg8::f32x4 (&acc)[2][2][4][2], const pg8::Unit& u, int wr, int wc, int fr, int fq) const {
        static_assert(D == 4096, "64 partial sums per row = 16 column tiles x 4 waves");
        const int row0 = u.pm * 256 + wr * 64 + fr, col0 = u.pn * 256 + wc * 32 + 4 * fq;
#pragma unroll
        for (int ai = 0; ai < 2; ++ai) {
            uint2 rv[4][2][2];
#pragma unroll
            for (int m = 0; m < 4; ++m)
#pragma unroll
                for (int bj = 0; bj < 2; ++bj)
#pragma unroll
                    for (int n = 0; n < 2; ++n) rv[m][bj][n] = *(const uint2*)(Xb + (size_t)(row0 + ai * 128 + m * 16) * ld + col0 + bj * 128 + n * 16);
            asm volatile("" ::: "memory");
#pragma unroll
            for (int m = 0; m < 4; ++m) {
                const int row = row0 + ai * 128 + m * 16; float ss = 0.f;
#pragma unroll
                for (int bj = 0; bj < 2; ++bj)
#pragma unroll
                    for (int n = 0; n < 2; ++n) {
                        const size_t o = (size_t)row * ld + col0 + bj * 128 + n * 16;
                        const uint2 rw = rv[m][bj][n];
                        const pg8::f32x4 r = (pg8::f32x4){__uint_as_float(rw.x << 16), __uint_as_float(rw.x & 0xffff0000u), __uint_as_float(rw.y << 16), __uint_as_float(rw.y & 0xffff0000u)};
                        const pg8::f32x4 v = acc[ai][bj][m][n] * cs + r;
                        *(uint2*)(Xb + o) = make_uint2(pk2(v[0], v[1]), pk2(v[2], v[3]));
                        if (X8) *(unsigned*)(X8 + o) = pk4f8(v[0] * F8S_X, v[1] * F8S_X, v[2] * F8S_X, v[3] * F8S_X);
                        ss += (v[0] * v[0] + v[1] * v[1]) + (v[2] * v[2] + v[3] * v[3]);
                    }
                ss += __shfl_xor(ss, 16); ss += __shfl_xor(ss, 32);
                if (fq == 0) part[(size_t)row * 64 + u.pn * 4 + wc] = ss;
            }
        }
    }
};
template <bool HAS8> struct EpiResidP {
    static constexpr bool PERM = true, AFTER_DRAIN = false;
    bf16_t* Xb; unsigned char* X8; float* part; float cs; int ld;
    __device__ __forceinline__ void operator()(const pg8::f32x4 (&acc)[2][2][4][2], const pg8::Unit& u, int wr, int wc, int fr, int fq) const {
        static_assert(D == 4096, "64 partial sums per row = 16 column tiles x 4 waves");
        const int row0 = u.pm * 256 + wr * 64 + fr, col0 = u.pn * 256 + wc * 32 + 8 * fq;
#pragma unroll
        for (int ai = 0; ai < 2; ++ai)
#pragma unroll
          for (int mh = 0; mh < 2; ++mh) {
            pg8::u32x4 rv[4][2];
#pragma unroll
            for (int m = 2 * mh; m < 2 * mh + 2; ++m)
#pragma unroll
                for (int bj = 0; bj < 2; ++bj) rv[m][bj] = *(const pg8::u32x4*)(Xb + (size_t)(row0 + ai * 128 + m * 16) * ld + col0 + bj * 128);
            asm volatile("" ::: "memory");
#pragma unroll
            for (int m = 2 * mh; m < 2 * mh + 2; ++m) {
                const int row = row0 + ai * 128 + m * 16; float ss = 0.f;
#pragma unroll
                for (int bj = 0; bj < 2; ++bj) {
                    const size_t o = (size_t)row * ld + col0 + bj * 128;
                    const pg8::u32x4 rw = rv[m][bj];
                    const pg8::f32x4 r0 = (pg8::f32x4){__uint_as_float(rw.x << 16), __uint_as_float(rw.x & 0xffff0000u), __uint_as_float(rw.y << 16), __uint_as_float(rw.y & 0xffff0000u)};
                    const pg8::f32x4 r1 = (pg8::f32x4){__uint_as_float(rw.z << 16), __uint_as_float(rw.z & 0xffff0000u), __uint_as_float(rw.w << 16), __uint_as_float(rw.w & 0xffff0000u)};
                    const pg8::f32x4 v0 = acc[ai][bj][m][0] * cs + r0, v1 = acc[ai][bj][m][1] * cs + r1;
                    pg8::u32x4 wv; wv.x = pk2(v0[0], v0[1]); wv.y = pk2(v0[2], v0[3]); wv.z = pk2(v1[0], v1[1]); wv.w = pk2(v1[2], v1[3]);
                    *(pg8::u32x4*)(Xb + o) = wv;
                    if constexpr (HAS8) *(uint2*)(X8 + o) = make_uint2(pk4f8(v0[0] * F8S_X, v0[1] * F8S_X, v0[2] * F8S_X, v0[3] * F8S_X), pk4f8(v1[0] * F8S_X, v1[1] * F8S_X, v1[2] * F8S_X, v1[3] * F8S_X));
                    ss += ((v0[0] * v0[0] + v0[1] * v0[1]) + (v0[2] * v0[2] + v0[3] * v0[3])) + ((v1[0] * v1[0] + v1[1] * v1[1]) + (v1[2] * v1[2] + v1[3] * v1[3]));
                }
                ss += __shfl_xor(ss, 16); ss += __shfl_xor(ss, 32);
                if (fq == 0) part[(size_t)row * 64 + u.pn * 4 + wc] = ss;
            }
        }
    }
};
DEVFN void b_ssq_reduce(const P& p, const int l, long gid) {
    const float* q = p.ssp() + (size_t)gid * 64; float s = 0.f;
    for (int i = 0; i < 64; ++i) s += q[i];
    p.sumsq()[gid] = s;
}
template <bool PERM_> struct EpiNull {
    static constexpr bool PERM = PERM_, AFTER_DRAIN = false;
    int dummy, pad;
    __device__ __forceinline__ void operator()(const pg8::f32x4 (&acc)[2][2][4][2], const pg8::Unit& u, int wr, int wc, int fr, int fq) const {
#pragma unroll
        for (int ai = 0; ai < 2; ++ai)
#pragma unroll
            for (int bj = 0; bj < 2; ++bj)
#pragma unroll
                for (int m = 0; m < 4; ++m)
#pragma unroll
                    for (int n = 0; n < 2; ++n) asm volatile("" :: "v"(acc[ai][bj][m][n]));
    }
};
struct EpiBf16S {
    static constexpr bool PERM = true, AFTER_DRAIN = false;
    bf16_t* O; const float* sumsq; int ld; int pad;
    __device__ __forceinline__ void operator()(const pg8::f32x4 (&acc)[2][2][4][2], const pg8::Unit& u, int wr, int wc, int fr, int fq) const {
        const int row0 = u.pm * 256 + wr * 64 + fr, col0 = u.pn * 256 + wc * 32 + 8 * fq;
#pragma unroll
        for (int ai = 0; ai < 2; ++ai)
#pragma unroll
            for (int m = 0; m < 4; ++m) {
                const int row = row0 + ai * 128 + m * 16;
                const float sc = sumsq ? 1.0f / sqrtf(sumsq[row] * (1.0f / (float)D) + RMS_EPS) : 1.0f;
#pragma unroll
                for (int bj = 0; bj < 2; ++bj) {
                    const pg8::f32x4 v0 = acc[ai][bj][m][0] * sc, v1 = acc[ai][bj][m][1] * sc;
                    pg8::u32x4 wv; wv.x = pk2(v0[0], v0[1]); wv.y = pk2(v0[2], v0[3]); wv.z = pk2(v1[0], v1[1]); wv.w = pk2(v1[2], v1[3]);
                    *(pg8::u32x4*)(O + (size_t)row * ld + col0 + bj * 128) = wv;
                }
            }
    }
};
DEVFN void b_cvt_plain(const float* __restrict__ src, bf16_t* __restrict__ dst, long gid) {
    const size_t i = (size_t)gid * 8; const float4 a = *(const float4*)(src + i), b = *(const float4*)(src + i + 4);
    *(uint4*)(dst + i) = make_uint4(pk2(a.x, a.y), pk2(a.z, a.w), pk2(b.x, b.y), pk2(b.z, b.w));
}

#define XB_TMO      128
#define XB_XCNT(j)  (256  + 64 * (j))
#define XB_XSUB(j)  (1280 + 64 * (j))
#define XB_XGEN(j)  (2304 + 64 * (j))
#define XB_TOP      3328
#define XB_TOPGEN   3392
#define XCD_BAR_WORDS 3456
#define XB_SPIN_CAP (1u << 18)

__device__ __forceinline__ unsigned xb_ld(unsigned* p)              { return __hip_atomic_load(p, __ATOMIC_RELAXED, __HIP_MEMORY_SCOPE_AGENT); }
__device__ __forceinline__ unsigned xb_add(unsigned* p, unsigned v) { return __hip_atomic_fetch_add(p, v, __ATOMIC_RELAXED, __HIP_MEMORY_SCOPE_AGENT); }
__device__ __forceinline__ unsigned xb_xcc_id() { return (unsigned)__builtin_amdgcn_s_getreg((3 << 11) | 20) & 0xFu; }
#define XB_SPIN(cond, bar) do { unsigned _sp = 0; while (cond) { __builtin_amdgcn_s_sleep(1); \
    if ((++_sp & 255u) == 0u) { if (xb_ld(&(bar)[XB_TMO])) break; if (_sp > XB_SPIN_CAP) { atomicAdd(&(bar)[XB_TMO], 1u); break; } } } } while (0)

struct XcdBarrier {
    unsigned* bar; unsigned x;
    volatile LAS unsigned* st;
};

__device__ __forceinline__ XcdBarrier xcd_barrier_post(unsigned* bar, volatile LAS unsigned* st) {
    XcdBarrier b; b.bar = bar; b.x = xb_xcc_id(); b.st = st;
    if (threadIdx.x == 0) (void)xb_add(&bar[XB_XCNT(b.x)], 1u);
    return b;
}
__device__ __forceinline__ void xcd_barrier_complete(unsigned* bar, unsigned x, unsigned& nloc, unsigned& nx) {
    const unsigned G = gridDim.x * gridDim.y * gridDim.z;
    unsigned sum, cnt, mine, sp = 0u;
    for (;;) {
        sum = 0u; cnt = 0u; mine = 0u;
#pragma unroll
        for (unsigned j = 0; j < 16; ++j) { const unsigned c = xb_ld(&bar[XB_XCNT(j)]); sum += c; cnt += (c > 0u) ? 1u : 0u; mine = (j == x) ? c : mine; }
        if (sum == G) break;
        __builtin_amdgcn_s_sleep(1);
        if ((++sp & 255u) == 0u) { if (xb_ld(&bar[XB_TMO])) break; if (sp > XB_SPIN_CAP) { atomicAdd(&bar[XB_TMO], 1u); break; } }
    }
    nloc = mine > 0u ? mine : 1u; nx = cnt > 0u ? cnt : 1u;
}

__device__ __forceinline__ void xcd_barrier(const XcdBarrier& b) {
    asm volatile("s_waitcnt vmcnt(0)" ::: "memory");
    __syncthreads();
    if (threadIdx.x == 0) {
        unsigned* bar = b.bar;
        __builtin_amdgcn_s_waitcnt(0);
        unsigned nloc = b.st[0], nx = b.st[1];
        if (nloc == 0u) { xcd_barrier_complete(bar, b.x, nloc, nx); b.st[0] = nloc; b.st[1] = nx; }
        const unsigned old = xb_add(&bar[XB_XSUB(b.x)], 1u);
        const unsigned gen = old / nloc;
        if (old + 1u == (gen + 1u) * nloc) {
            __builtin_amdgcn_fence(__ATOMIC_RELEASE, "agent");
            asm volatile("s_waitcnt vmcnt(0)" ::: "memory");
            const unsigned og = xb_add(&bar[XB_TOP], 1u);
            const unsigned tg = og / nx;
            if (og + 1u == (tg + 1u) * nx) xb_add(&bar[XB_TOPGEN], 1u);
            else XB_SPIN(xb_ld(&bar[XB_TOPGEN]) == tg, bar);
            __builtin_amdgcn_fence(__ATOMIC_ACQUIRE, "agent");
            xb_add(&bar[XB_XGEN(b.x)], 1u);
            asm volatile("s_waitcnt vmcnt(0)" ::: "memory");
        } else {
            XB_SPIN(xb_ld(&bar[XB_XGEN(b.x)]) == gen, bar);
            __builtin_amdgcn_fence(__ATOMIC_ACQUIRE, "agent");
            asm volatile("s_waitcnt vmcnt(0)" ::: "memory");
        }
    }
    __syncthreads();
}


#define VLOOP_SUB(n, first, cnt, call) do { const long _n = (long)(n); const int _vb = bid_fresh() - (first); const int _t = tid_fresh(); if (_vb >= 0 && _vb < (cnt)) \
    for (long _w = (long)(_t >> 6) * (cnt) + _vb; _w * 64 < _n; _w += 8L * (cnt)) { const long gid = _w * 64 + (_t & 63); if (gid < _n) { call; } } } while (0)
#define VLOOP(n, rot, wrot, call) do { const long _n = (long)(n); const int _G = (int)gridDim.x; const int _vb = (int)((bid_fresh() + _G - ((rot) % _G)) % _G); const int _t = tid_fresh(); \
    for (long _w = (long)(((_t >> 6) + (wrot)) & 7) * _G + _vb; _w * 64 < _n; _w += 8L * _G) { const long gid = _w * 64 + (_t & 63); if (gid < _n) { call; } } } while (0)

template <bool F8 = false> DEVFN void ph_cvt_t(LAS float* tile, const float* __restrict__ src, int N, int K, bf16_t* __restrict__ dst, int Npad, const float* __restrict__ g, const float f8scale = 1.f) {
    const int tid = tid_fresh(), ntn = Npad / 128, ntk = K / 128, nt = ntn * ntk, ty = tid >> 5, tx = tid & 31, nn = tid >> 2, ks = (tid & 3) * 32;
    float4 v[8];
#define CVT_LOAD(ti_) do { const int _n0 = ((ti_) % ntn) * 128, _k0 = ((ti_) / ntn) * 128; _Pragma("unroll") for (int r = 0; r < 8; ++r) { const int kk = ty + 16 * r, n = _n0 + tx * 4; \
        v[r] = make_float4(0.f, 0.f, 0.f, 0.f); if (n + 4 <= N) v[r] = *(const float4*)(src + (size_t)(_k0 + kk) * N + n); } } while (0)
    int ti = bid_fresh();
    if (ti < nt) CVT_LOAD(ti);
    for (; ti < nt; ti += gridDim.x) {
        const int n0 = (ti % ntn) * 128, k0 = (ti / ntn) * 128;
#pragma unroll
        for (int r = 0; r < 8; ++r) { const int kk = ty + 16 * r; const float gq = g ? g[k0 + kk] : 1.0f; tile[kk * 129 + tx * 4 + 0] = v[r].x * gq; tile[kk * 129 + tx * 4 + 1] = v[r].y * gq; tile[kk * 129 + tx * 4 + 2] = v[r].z * gq; tile[kk * 129 + tx * 4 + 3] = v[r].w * gq; }
        if (ti + (int)gridDim.x < nt) CVT_LOAD(ti + (int)gridDim.x);
        __syncthreads();
        if constexpr (F8) {
            unsigned w[8];
#pragma unroll
            for (int i = 0; i < 8; ++i) w[i] = pk4f8(tile[(ks + 4 * i) * 129 + nn] * f8scale, tile[(ks + 4 * i + 1) * 129 + nn] * f8scale, tile[(ks + 4 * i + 2) * 129 + nn] * f8scale, tile[(ks + 4 * i + 3) * 129 + nn] * f8scale);
            uint4* d = (uint4*)((unsigned char*)dst + (size_t)(n0 + nn) * K + k0 + ks);
            d[0] = make_uint4(w[0], w[1], w[2], w[3]); d[1] = make_uint4(w[4], w[5], w[6], w[7]);
        } else {
            unsigned w[16];
#pragma unroll
            for (int i = 0; i < 16; ++i) w[i] = pack2bf(tile[(ks + 2 * i) * 129 + nn], tile[(ks + 2 * i + 1) * 129 + nn]);
            uint4* d = (uint4*)(dst + (size_t)(n0 + nn) * K + k0 + ks);
            d[0] = make_uint4(w[0], w[1], w[2], w[3]); d[1] = make_uint4(w[4], w[5], w[6], w[7]); d[2] = make_uint4(w[8], w[9], w[10], w[11]); d[3] = make_uint4(w[12], w[13], w[14], w[15]);
        }
        __syncthreads();
    }
#undef CVT_LOAD
}
DEVFN void ph_xprep(const float* __restrict__ x, bf16_t* __restrict__ xb, float* __restrict__ sumsq, unsigned char* __restrict__ xq8 = nullptr) {
    const int tid = tid_fresh(), lane = tid & 63;
    for (int row = (int)(tid >> 6) * (int)gridDim.x + bid_fresh(); row < T; row += 8 * (int)gridDim.x) {
        const float4* r = (const float4*)(x + (size_t)row * D); uint2* o = (uint2*)(xb + (size_t)row * D); float s = 0.f;
        for (int i = lane; i < D / 4; i += 64) { const float4 v = r[i]; s += v.x * v.x + v.y * v.y + v.z * v.z + v.w * v.w; o[i] = make_uint2(pack2bf(v.x, v.y), pack2bf(v.z, v.w));
            if (xq8) ((unsigned*)(xq8 + (size_t)row * D))[i] = pk4f8(v.x * F8S_X, v.y * F8S_X, v.z * F8S_X, v.w * F8S_X); }
        for (int off = 32; off >= 1; off >>= 1) s += __shfl_xor(s, off);
        if (lane == 0) sumsq[row] = s;
    }
}
DEVFN void ph_final(const bf16_t* __restrict__ x, const float* __restrict__ g, float* __restrict__ out) {
    const int tid = tid_fresh(), lane = tid & 63;
    for (int row = (int)(tid >> 6) * (int)gridDim.x + bid_fresh(); row < T; row += 8 * (int)gridDim.x) {
        const uint2* r = (const uint2*)(x + (size_t)row * D); float4* o = (float4*)(out + (size_t)row * D); float s = 0.f;
        for (int i = lane; i < D / 4; i += 64) { const uint2 w = r[i]; const float a = __uint_as_float(w.x << 16), b = __uint_as_float(w.x & 0xffff0000u), c = __uint_as_float(w.y << 16), d = __uint_as_float(w.y & 0xffff0000u); s += a * a + b * b + c * c + d * d; }
        for (int off = 32; off >= 1; off >>= 1) s += __shfl_xor(s, off);
        const float rs = 1.0f / sqrtf(s * (1.0f / (float)D) + RMS_EPS);
        for (int i = lane; i < D / 4; i += 64) { const uint2 w = r[i]; const float4 gg = ((const float4*)g)[i];
            o[i] = make_float4(__uint_as_float(w.x << 16) * rs * gg.x, __uint_as_float(w.x & 0xffff0000u) * rs * gg.y, __uint_as_float(w.y << 16) * rs * gg.z, __uint_as_float(w.y & 0xffff0000u) * rs * gg.w); }
    }
}
template <bool SP2, class Epi, bool F8 = false> DEVFN void ph_gemm(LAS unsigned char* lds, const bf16_t* A, const bf16_t* Bt, int M, int N, int K, const Epi& E, const int wgm = 4) {
    asm volatile("" : "+s"(K), "+s"(M), "+s"(N));
    pg8::Gemm g; g.A = A; g.Bt = Bt; g.M = M; g.N = N; g.K = K;
    pg8::StaticOrder So; So.init(M, N, (int)gridDim.x, bid_fresh(), wgm);
    pg8::gemm_phase<Epi, pg8::StaticOrder, true, SP2, F8>(lds, g, So, E);
}

#ifndef WGM_P1
#define WGM_P1 4
#endif
#ifndef WGM_P5
#define WGM_P5 4
#endif
#ifndef WGM_P8
#define WGM_P8 4
#endif
#ifndef WGM_P9
#define WGM_P9 8
#endif
#ifndef MK_LAUNCHES
#define MK_LAUNCHES 1
#endif
constexpr int NPH = 11, NPH_ALL = NL * NPH + 1;
constexpr int LDS_BYTES = pg8::STAGE_BYTES + 64;
struct Args { P p; int ph_lo, ph_hi, use_bar, pad; };

DEVFN bool in_range(int k, const int lo, const int hi) { asm volatile("" : "+s"(k)); return lo <= k && k < hi; }
__global__ void __launch_bounds__(512, 2) fwd(Args a) {
    extern __shared__ __attribute__((aligned(16))) unsigned char lds_raw[];
    LAS unsigned char* lds = (LAS unsigned char*)lds_raw;
    volatile LAS unsigned* st = (volatile LAS unsigned*)(lds + pg8::STAGE_BYTES);
    if (threadIdx.x == 0) { st[0] = 0u; st[1] = 0u; st[2] = 0u; st[3] = 0u; }
    __syncthreads();
    XcdBarrier bar; bar.bar = a.p.bar(); bar.x = 0; bar.st = st;
    if (a.use_bar) bar = xcd_barrier_post(a.p.bar(), st);
    const P& p = a.p;
    const int lo = a.ph_lo, hi = a.ph_hi;
    LAS float* tile = (LAS float*)lds;
#define IN(k) in_range((k), lo, hi)
#define SEAM(k) do { if (IN((k) + 1)) xcd_barrier(bar); } while (0)
#ifndef PROBE_MASK
#define PROBE_MASK 0
#endif
#ifndef PROBE_SUB
#define PROBE_SUB 0
#endif
#define RX(n, ...) { __VA_ARGS__ if (PROBE_SUB == (n)) { __syncthreads(); __VA_ARGS__ } }
#define PH(k, ...) if (IN(b + (k))) { int l = lay; P pl_ = a.p; asm volatile("" : "+s"(l), "+s"(pl_.ws));     \
    const P& p = pl_; _Pragma("unroll 1") for (int _rep = 0; _rep <= ((PROBE_MASK >> (k)) & 1); ++_rep) { __VA_ARGS__ if (_rep < ((PROBE_MASK >> (k)) & 1)) xcd_barrier(bar); } SEAM(b + (k)); }
    for (int lay = 0; lay < NL; ++lay) {
        const int b = lay * NPH;
        PH(0,
            ph_cvt_t<true>(tile, p.w_out + (size_t)l * D * D, D, D, p.WoutT(), D, nullptr, F8S_W);
            ph_cvt_t(tile, p.peer_wq + (size_t)l * D * PE_QW, PE_QW, D, p.WqT(), PE_QW, p.norm2_g + (size_t)l * D);
            ph_cvt_t(tile, p.s5_w_glu + (size_t)l * GW * GW, GW, GW, p.GluT(), GW, nullptr);
            ph_cvt_t<true>(tile, p.peer_v + (size_t)l * PE_E * D, D, PE_E, (bf16_t*)p.Vt8(), D, nullptr, F8S_V);
            ph_cvt8_stream(p.peer_u + (size_t)l * PE_E * D, p.U8(), p.norm2_g + (size_t)l * D, D, F8S_U, (long)PE_E * D / 8);
            VLOOP((long)PE_H * 2 * PE_NK * PE_DH / 8, 0, 0, b_cvt_plain(p.peer_subkeys + (size_t)l * PE_H * 2 * PE_NK * PE_DH, p.skb(), gid));
            VLOOP((long)LRU_NBLK * 256 * 16, 0, 0, b_lru_wprep2(p, l, gid));
            VLOOP((long)S5_GP, 0, 0, b_s5_pre2(p, l, gid)); VLOOP((long)S5_GP * (S5_L + 1), 0, 1, b_s5_pw(p, l, gid));
            ph_cvt_t(tile, p.w_in + (size_t)l * D * INW, INW, D, p.WinT(), PLD, p.norm1_g + (size_t)l * D);
            if (l == 0) ph_xprep(p.x, p.xbf(), p.sumsq()); else VLOOP((long)T, 0, 0, b_ssq_reduce(p, l, gid));)
        PH(1,
            { EpiBf16S e; e.O = p.pjb(); e.sumsq = p.sumsq(); e.ld = PLD; e.pad = 0; ph_gemm<true>(lds, p.xbf(), p.WinT(), T, PLD, D, e, WGM_P1); }
#if PROBE_SUB == 21
            { xcd_barrier(bar); EpiNull<true> e; e.dummy = 0; e.pad = 0; ph_gemm<true>(lds, p.xbf(), p.WinT(), T, PLD, D, e); }
#endif
            { constexpr int NU = (T / 256) * (PLD / 256), FIRST = NU % 256, CNT = 256 - FIRST;
              if (gridDim.x == 256 && CNT >= 96) { ph_s5_ktoep(p, l, lds, FIRST, 64); VLOOP_SUB((long)S5_G * S5_P2 * 128, FIRST, CNT, b_s5_wend(p, l, gid)); VLOOP_SUB((long)S5_G * S5_K * 16, FIRST, CNT, b_s5_mc(p, l, gid)); }
              else { VLOOP((long)S5_G * S5_L * 256, 0, 0, b_s5_ktoep(p, l, gid)); VLOOP((long)S5_G * S5_P2 * 128, 0, 0, b_s5_wend(p, l, gid)); VLOOP((long)S5_G * S5_K * 16, 0, 0, b_s5_mc(p, l, gid)); } })
        PH(2,
            RX(1, VLOOP((long)(T / 4) * (GW / 8), 0, 0, b_lru_conv3(p, l, gid));) RX(2, ph_gla_s1(p, l, lds);) RX(3, ph_s5_e(p, l);) RX(4, ph_mb_prep(p, lds);))
        PH(3,
            { EpiLru2 e; e.LA = p.lA(); e.LB = p.lB(); e.xcb = p.lxcb(); e.ba = p.lru_ba + (size_t)l * GW; e.bx = p.lru_bx + (size_t)l * GW; e.lam = p.lru_lambda + (size_t)l * GW;
              RX(5, { int Kb = LRU_BLK; asm volatile("" : "+s"(Kb)); pg8::Gemm g; g.A = p.lxcb(); g.Bt = p.lruW(); g.M = LRU_NBLK * T; g.N = LRU_NBLK * 256; g.K = Kb; DiagOrder So; So.c = bid_fresh(); So.G = (int)gridDim.x; pg8::gemm_phase<EpiLru2, DiagOrder, true, true, false>(lds, g, So, e); }) }
            RX(6, VLOOP((long)NB * GLA_H * GLA_DV * (GLA_DK / 2), 0, 0, b_gla_s2x(p, l, gid));) RX(7, ph_s5_y(p, l, lds);) RX(8, ph_mb_sel(p, lds);))
        PH(4,
            { EpiGlu e; e.O = (unsigned char*)p.mixedb() + 2 * GW; e.Z = p.s5zb(); e.bias = p.s5_b_glu + (size_t)l * GW; e.ldo = D; e.ldz = GW; ph_gemm<true>(lds, p.s5zb(), p.GluT(), T, GW, GW, e); }
            {
                volatile LAS unsigned* qw = (volatile LAS unsigned*)(lds + pg8::STAGE_BYTES + 32);
                unsigned* qc = p.bar() + XCD_BAR_WORDS + l;
                constexpr int NSC = NB * (GW / 8);
                for (;;) {
                    __syncthreads();
                    if (tid_fresh() == 0) *qw = xb_add(qc, 1u);
                    __syncthreads();
                    const int u = __builtin_amdgcn_readfirstlane((int)*qw);
                    if (u >= MB_PAIRS + NSC + GLA_UNITS) break;
                    if (u < MB_PAIRS) mb_attn_pair(p, lds, u);
                    else if (u < MB_PAIRS + NSC) ph_lru_scan(p, l, lds, u - MB_PAIRS, u - MB_PAIRS + 1, 1);
                    else ph_gla_s3(p, l, lds, u - MB_PAIRS - NSC, u - MB_PAIRS - NSC + 1, 1);
                }
            })
        PH(5,
            { EpiResidP<true> e; e.Xb = p.xbf(); e.X8 = p.xq8(); e.part = p.ssp(); e.cs = 1.0f / (F8S_M * F8S_W); e.ld = D; ph_gemm<true, EpiResidP<true>, true>(lds, p.mixedb(), p.WoutT(), T, D, D / 2, e, WGM_P5); })
        PH(6,
            { EpiBf16S e; e.O = p.pqb(); e.sumsq = nullptr; e.ld = PE_QW; e.pad = 0; ph_gemm<true>(lds, p.xbf(), p.WqT(), T, PE_QW, D, e); })
#ifdef PROBE_ROUTE
        PH(7, ph_pe_route(p, l, lds, true); xcd_barrier(bar); ph_pe_route(p, l, lds);)
#else
        PH(7,
            ph_pe_route(p, l, lds);)
#endif
        PH(8,
            { EpiPeer1A e; e.A = p.A16(); e.Pm = p.P8(); e.sumsq = p.sumsq(); e.ld = PE_E; e.pad = 0; ph_gemm<true, EpiPeer1A, true>(lds, (const bf16_t*)p.xq8(), (const bf16_t*)p.U8(), T, PE_E, D / 2, e, WGM_P8); })
        PH(9,
            ph_pe_apply(p, lds);)
        PH(10,
            { EpiResidP<false> e; e.Xb = p.xbf(); e.X8 = nullptr; e.part = p.ssp(); e.cs = 1.0f / (F8S_P * F8S_V); e.ld = D; ph_gemm<true, EpiResidP<false>, true>(lds, (const bf16_t*)p.P8(), (const bf16_t*)p.Vt8(), T, D, PE_E / 2, e, WGM_P9); })
    }
    if (IN(NL * NPH)) ph_final(a.p.xbf(), a.p.final_norm_g, a.p.out);
#undef IN
#undef SEAM
#undef PH
}

extern "C" void kernel_launch(void* const* d_in, const int* in_sizes, int n_in, void* d_out, int out_size, void* d_ws, size_t ws_size, hipStream_t stream) {
    Args a{};
    P& p = a.p;
    const float** ins = (const float**)&p.x;
    for (int i = 0; i < 30; ++i) ins[i] = (const float*)d_in[i];
    p.out = (float*)d_out;
    p.ws = (unsigned char*)d_ws;
    if (WSL.end > ws_size) return;
    static int grid = 0;
    if (grid == 0) {
        int dev = 0, cus = 0;
        if (hipGetDevice(&dev) != hipSuccess || hipDeviceGetAttribute(&cus, hipDeviceAttributeMultiprocessorCount, dev) != hipSuccess) { grid = -1; return; }
        if (hipFuncSetAttribute((const void*)fwd, hipFuncAttributeMaxDynamicSharedMemorySize, LDS_BYTES) != hipSuccess) { grid = -1; return; }
        int per_cu = 0;
        if (hipOccupancyMaxActiveBlocksPerMultiprocessor(&per_cu, (const void*)fwd, 512, LDS_BYTES) != hipSuccess || per_cu < 1) { (void)hipGetLastError(); }
        grid = cus;
    }
    if (grid < 0) return;
    (void)hipMemsetAsync((unsigned char*)d_ws + WSL.bar, 0, XCD_BAR_WORDS * sizeof(unsigned) + 256, stream);
#if MK_LAUNCHES == 1
    a.ph_lo = 0; a.ph_hi = NPH_ALL; a.use_bar = 1;
    hipLaunchKernelGGL(fwd, dim3(grid), dim3(512), LDS_BYTES, stream, a);
#else
    for (int ph = 0; ph < NPH_ALL; ++ph) { a.ph_lo = ph; a.ph_hi = ph + 1; a.use_bar = 0; hipLaunchKernelGGL(fwd, dim3(grid), dim3(512), LDS_BYTES, stream, a); }
#endif
}
```
